# Optimizing an MI355X kernel written in HIP

```python
import jax, jax.numpy as jnp
from jax import lax
import numpy as np

D_MODEL = 2048
BATCH = 4
SEQ = 2048
DEPTH = 1

D_MIX = D_MODEL
ATTN_WIDTH = D_MIX // 2
HGRN_WIDTH = D_MIX - ATTN_WIDTH
ATTN_HEAD_DIM = 128
N_ATTN_HEADS = ATTN_WIDTH // ATTN_HEAD_DIM
HGRN_HEAD_DIM = 128
N_HGRN_HEADS = HGRN_WIDTH // HGRN_HEAD_DIM
IN_COLS = 3 * ATTN_WIDTH + 4 * HGRN_WIDTH
MOBA_BLOCK = 256
MOBA_TOPK = 3
MOBA_Q_BLOCK = 64
HGRN_CHUNK = 64
N_GROUPS = 4
EXPERTS_PER_GROUP = 4
N_EXPERTS = N_GROUPS * EXPERTS_PER_GROUP
TOPK_IN_GROUP = 2
D_EXPERT = D_MODEL // 2
RMS_EPS = 1e-6

kernel_name = "hymba_moba_hgrn2_hmoe_block"


def rms_norm(x, g):
    xf = x.astype(jnp.float32)
    y = xf * lax.rsqrt(jnp.mean(xf * xf, axis=-1, keepdims=True) + RMS_EPS)
    return (y * g.astype(jnp.float32)).astype(x.dtype)


def alibi_slopes(n_heads):
    return jnp.asarray(2.0 ** (-8.0 * np.arange(1, n_heads + 1) / n_heads), dtype=jnp.float32)


def moba_attention(q, k, v):
    B, H, T, Dh = q.shape
    Tp = -(-T // MOBA_BLOCK) * MOBA_BLOCK
    if Tp != T:
        pad = ((0, 0), (0, 0), (0, Tp - T), (0, 0))
        q, k, v = jnp.pad(q, pad), jnp.pad(k, pad), jnp.pad(v, pad)
    nb = Tp // MOBA_BLOCK
    k_top = min(MOBA_TOPK, nb)
    scale = Dh ** -0.5
    slopes = alibi_slopes(H)
    kb = k.reshape(B, H, nb, MOBA_BLOCK, Dh)
    vb = v.reshape(B, H, nb, MOBA_BLOCK, Dh)
    k_mean = jnp.mean(kb.astype(jnp.float32), axis=3)
    gate = jnp.einsum('bhtd,bhnd->bhtn', q.astype(jnp.float32), k_mean)
    q_blk = jnp.arange(Tp) // MOBA_BLOCK
    past = jnp.arange(nb)[None, :] < q_blk[:, None]
    gate = jnp.where(past[None, None], gate, -jnp.inf)
    _, sel = lax.top_k(gate, k_top)
    sel_valid = sel < q_blk[None, None, :, None]

    n_qb = Tp // MOBA_Q_BLOCK

    def to_blocks(a):
        a = a.reshape(B, H, n_qb, MOBA_Q_BLOCK, *a.shape[3:])
        return jnp.moveaxis(a, 2, 0)

    gather_blocks = jax.vmap(jax.vmap(lambda blocks, idx: blocks[idx]))

    def step(args):
        qc, selc, validc, ci = args
        t_pos = ci * MOBA_Q_BLOCK + jnp.arange(MOBA_Q_BLOCK)
        own = (ci * MOBA_Q_BLOCK) // MOBA_BLOCK
        k_g = gather_blocks(kb, selc)
        v_g = gather_blocks(vb, selc)
        s_sel = jnp.einsum('bhqd,bhqkcd->bhqkc', qc, k_g,
                           preferred_element_type=jnp.float32) * scale
        key_pos = selc[..., None] * MOBA_BLOCK + jnp.arange(MOBA_BLOCK)
        dist_sel = (t_pos[None, None, :, None, None] - key_pos).astype(jnp.float32)
        s_sel = s_sel - slopes[None, :, None, None, None] * dist_sel
        s_sel = jnp.where(validc[..., None], s_sel, -jnp.inf)
        k_own = lax.dynamic_slice_in_dim(k, own * MOBA_BLOCK, MOBA_BLOCK, axis=2)
        v_own = lax.dynamic_slice_in_dim(v, own * MOBA_BLOCK, MOBA_BLOCK, axis=2)
        s_own = jnp.einsum('bhqd,bhcd->bhqc', qc, k_own,
                           preferred_element_type=jnp.float32) * scale
        dist_own = t_pos[:, None] - (own * MOBA_BLOCK + jnp.arange(MOBA_BLOCK))[None, :]
        s_own = s_own - slopes[:, None, None] * dist_own.astype(jnp.float32)
        s_own = jnp.where((dist_own >= 0)[None, None], s_own, -jnp.inf)
        n_sel = k_top * MOBA_BLOCK
        s = jnp.concatenate([s_sel.reshape(B, H, MOBA_Q_BLOCK, n_sel), s_own], axis=-1)
        p = jax.nn.softmax(s, axis=-1).astype(v.dtype)
        p_sel = p[..., :n_sel].reshape(B, H, MOBA_Q_BLOCK, k_top, MOBA_BLOCK)
        p_own = p[..., n_sel:]
        return (jnp.einsum('bhqkc,bhqkcd->bhqd', p_sel, v_g)
                + jnp.einsum('bhqc,bhcd->bhqd', p_own, v_own))

    out = lax.map(step, (to_blocks(q), to_blocks(sel), to_blocks(sel_valid),
                         jnp.arange(n_qb)))
    out = jnp.moveaxis(out, 0, 2).reshape(B, H, Tp, Dh)
    return out[:, :, :T]


def hgrn2(q, f_logit, i, g, lb, out_norm_g):
    B, T, H, Dk = q.shape
    Dv = i.shape[-1]
    dt = q.dtype
    qf = jax.nn.silu(q.astype(jnp.float32))
    f = lb.astype(jnp.float32) + (1.0 - lb.astype(jnp.float32)) * jax.nn.sigmoid(f_logit.astype(jnp.float32))
    kf = 1.0 - f
    log_f = jnp.log(f)
    vf = i.astype(jnp.float32)
    C = HGRN_CHUNK
    n = T // C

    def to_chunks(a):
        return a.reshape(B, n, C, H, a.shape[-1]).transpose(1, 0, 3, 2, 4)

    causal = jnp.tril(jnp.ones((C, C), dtype=bool))

    def chunk_step(S, inp):
        qc, kc, vc, lfc = inp
        b = jnp.cumsum(lfc, axis=2)
        inter = jnp.einsum('bhtk,bhkv->bhtv', qc * jnp.exp(b), S)
        diff = b[:, :, :, None, :] - b[:, :, None, :, :]
        decay = jnp.exp(jnp.where(causal[None, None, :, :, None], diff, -jnp.inf))
        A = jnp.einsum('bhtk,bhsk,bhtsk->bhts', qc, kc, decay)
        intra = jnp.einsum('bhts,bhsv->bhtv', A, vc)
        b_last = b[:, :, -1:, :]
        S_new = (jnp.exp(b_last[:, :, 0, :])[..., None] * S
                 + jnp.einsum('bhsk,bhsv->bhkv', kc * jnp.exp(b_last - b), vc))
        return S_new, inter + intra

    S0 = jnp.zeros((B, H, Dk, Dv), jnp.float32)
    _, o = lax.scan(chunk_step, S0, (to_chunks(qf), to_chunks(kf), to_chunks(vf), to_chunks(log_f)))
    o = o.transpose(1, 0, 3, 2, 4).reshape(B, T, H, Dv)
    o = rms_norm(o, out_norm_g) * jax.nn.silu(g.astype(jnp.float32))
    return o.reshape(B, T, H * Dv).astype(dt)


def hier_moe(h, w_grp, b_grp, w_er, b_er, w_gate, w_up, w_down):
    B, T, D = h.shape
    hf = h.reshape(B * T, D)
    grp_prob = jax.nn.softmax((hf @ w_grp).astype(jnp.float32) + b_grp.astype(jnp.float32), axis=-1)
    grp_w, grp_idx = lax.top_k(grp_prob, 1)
    exp_logits = (jnp.einsum('nd,gde->nge', hf, w_er).astype(jnp.float32)
                  + b_er.astype(jnp.float32)[None])
    exp_logits = jnp.take_along_axis(exp_logits, grp_idx[:, :, None], axis=1)[:, 0]
    exp_prob = jax.nn.softmax(exp_logits, axis=-1)
    top_w, top_idx = lax.top_k(exp_prob, TOPK_IN_GROUP)
    top_w = top_w / jnp.sum(top_w, axis=-1, keepdims=True) * grp_w
    global_idx = grp_idx * EXPERTS_PER_GROUP + top_idx
    combine = jnp.sum(jax.nn.one_hot(global_idx, N_EXPERTS, dtype=jnp.float32)
                      * top_w[..., None], axis=1).astype(h.dtype)
    out = jnp.zeros_like(hf)
    for gi in range(N_GROUPS):
        sl = slice(gi * EXPERTS_PER_GROUP, (gi + 1) * EXPERTS_PER_GROUP)
        a = jnp.einsum('nd,edf->nef', hf, w_gate[sl])
        u = jnp.einsum('nd,edf->nef', hf, w_up[sl])
        hid = jax.nn.silu(a) * u * combine[:, sl, None]
        out = out + jnp.einsum('nef,efd->nd', hid, w_down[sl])
    return out.reshape(B, T, D)


def setup_inputs(seed: int = 0) -> dict:
    key = jax.random.key(seed)
    ks = jax.random.split(key, 16)
    f32 = jnp.float32

    def nrm(k, shape, scale):
        return jax.random.normal(k, shape, f32) * scale

    return {
        "x": nrm(ks[0], (BATCH, SEQ, D_MODEL), 1.0),
        "norm_mix_g": 1.0 + nrm(ks[1], (DEPTH, D_MODEL), 0.02),
        "w_in": nrm(ks[2], (DEPTH, D_MODEL, IN_COLS), D_MODEL ** -0.5),
        "hgrn_lb_logits": nrm(ks[3], (DEPTH + 1, HGRN_WIDTH), 0.5),
        "hgrn_out_norm_g": 1.0 + nrm(ks[4], (DEPTH, HGRN_HEAD_DIM), 0.02),
        "w_out": nrm(ks[5], (DEPTH, D_MIX, D_MODEL), D_MIX ** -0.5),
        "norm_ffn_g": 1.0 + nrm(ks[6], (DEPTH, D_MODEL), 0.02),
        "w_group_router": nrm(ks[7], (DEPTH, D_MODEL, N_GROUPS), D_MODEL ** -0.5),
        "b_group_router": nrm(ks[8], (DEPTH, N_GROUPS), 0.01),
        "w_expert_router": nrm(ks[9], (DEPTH, N_GROUPS, D_MODEL, EXPERTS_PER_GROUP), D_MODEL ** -0.5),
        "b_expert_router": nrm(ks[10], (DEPTH, N_GROUPS, EXPERTS_PER_GROUP), 0.01),
        "w_gate": nrm(ks[11], (DEPTH, N_EXPERTS, D_MODEL, D_EXPERT), D_MODEL ** -0.5),
        "w_up": nrm(ks[12], (DEPTH, N_EXPERTS, D_MODEL, D_EXPERT), D_MODEL ** -0.5),
        "w_down": nrm(ks[13], (DEPTH, N_EXPERTS, D_EXPERT, D_MODEL), D_EXPERT ** -0.5),
        "final_norm_g": 1.0 + nrm(ks[14], (D_MODEL,), 0.02),
    }


def reference(x, norm_mix_g, w_in, hgrn_lb_logits, hgrn_out_norm_g, w_out, norm_ffn_g,
              w_group_router, b_group_router, w_expert_router, b_expert_router,
              w_gate, w_up, w_down, final_norm_g):
    B, T, _ = x.shape
    lb_all = jnp.cumsum(jax.nn.softmax(hgrn_lb_logits.astype(jnp.float32), axis=0), axis=0)[:DEPTH]
    for l in range(DEPTH):
        h = rms_norm(x, norm_mix_g[l])
        proj = h @ w_in[l]
        o0 = 0
        q_a = proj[..., o0:o0 + ATTN_WIDTH]; o0 += ATTN_WIDTH
        k_a = proj[..., o0:o0 + ATTN_WIDTH]; o0 += ATTN_WIDTH
        v_a = proj[..., o0:o0 + ATTN_WIDTH]; o0 += ATTN_WIDTH
        q_r = proj[..., o0:o0 + HGRN_WIDTH]; o0 += HGRN_WIDTH
        f_r = proj[..., o0:o0 + HGRN_WIDTH]; o0 += HGRN_WIDTH
        i_r = proj[..., o0:o0 + HGRN_WIDTH]; o0 += HGRN_WIDTH
        g_r = proj[..., o0:o0 + HGRN_WIDTH]

        def heads(a):
            return a.reshape(B, T, N_ATTN_HEADS, ATTN_HEAD_DIM).transpose(0, 2, 1, 3)

        o_attn = moba_attention(heads(q_a), heads(k_a), heads(v_a))
        o_attn = o_attn.transpose(0, 2, 1, 3).reshape(B, T, ATTN_WIDTH)

        def rheads(a):
            return a.reshape(B, T, N_HGRN_HEADS, HGRN_HEAD_DIM)

        o_rec = hgrn2(rheads(q_r), rheads(f_r), rheads(i_r), rheads(g_r),
                      lb_all[l].reshape(N_HGRN_HEADS, HGRN_HEAD_DIM), hgrn_out_norm_g[l])
        x = x + jnp.concatenate([o_attn, o_rec], axis=-1) @ w_out[l]

        h2 = rms_norm(x, norm_ffn_g[l])
        x = x + hier_moe(h2, w_group_router[l], b_group_router[l], w_expert_router[l],
                         b_expert_router[l], w_gate[l], w_up[l], w_down[l])
    return rms_norm(x, final_norm_g)
```

```cpp
#include <hip/hip_runtime.h>
#include <cstdio>
#include <cstdint>

#ifndef MK_N_LAUNCHES
#define MK_N_LAUNCHES 1
#endif

namespace pg8 {
#define PG8_LAS __attribute__((address_space(3)))
typedef unsigned short bf16_t;
typedef short bf16x8 __attribute__((ext_vector_type(8)));
typedef float f32x4 __attribute__((ext_vector_type(4)));
typedef unsigned u32x4 __attribute__((ext_vector_type(4)));
constexpr int BM = 256, BK = 64, HALF = 128, HTB = HALF * BK * 2, STAGE_BYTES = 8 * HTB, NXCD = 8, WGM = 8;

__host__ __device__ __forceinline__ int lds_chunk(int r, int ch) { return r * 128 + ((ch ^ ((r >> 1) & 7)) << 4); }
__host__ __device__ __forceinline__ void stage_rc(int b, int& R, int& C) { R = b / 128; const int chp = (b % 128) / 16, ch = chp ^ ((R >> 1) & 7); C = ch * 8; }
__host__ __device__ __forceinline__ int perm32(int rho) { const int n = rho >> 4, i = rho & 15; return 8 * (i >> 2) + 4 * n + (i & 3); }

struct Unit { int pm, pn, e; const char* a; const char* b; const int* rows; const float* wl; int nvalid; };

struct StaticOrder {
    int nM, nN, nwg, G, c; const char* A; const char* Bt; size_t tstep;
    __device__ void init(const void* A_, const void* Bt_, int M, int N, int K, int G_, int c_) { nM = M / BM; nN = N / BM; nwg = nM * nN; G = G_; c = c_; A = (const char*)A_; Bt = (const char*)Bt_; tstep = (size_t)BM * K * 2; }
    __device__ bool next(int i, Unit& u) const {
        const long L = (long)i * G + c; if (L >= nwg) return false;
        int wgid = (int)L; { const int q = nwg / NXCD, r = nwg % NXCD, xcd = wgid % NXCD, off = wgid / NXCD; wgid = (xcd < r ? xcd * (q + 1) : r * (q + 1) + (xcd - r) * q) + off; }
        const int nig = WGM * nN, gid = wgid / nig, fm = gid * WGM, gsz = (nM - fm) < WGM ? (nM - fm) : WGM;
        u.pm = fm + ((wgid % nig) % gsz); u.pn = (wgid % nig) / gsz; u.e = 0;
        u.a = A + (size_t)u.pm * tstep; u.b = Bt + (size_t)u.pn * tstep; u.rows = nullptr; u.wl = nullptr; u.nvalid = 256; return true;
    }
};
struct GroupedOrder {
    int ntile, G, c; const char* A; const char* Bt; size_t a_tstep, b_tstep, b_estep; const PG8_LAS int* pre; const PG8_LAS int* cnt; const int* rowl; const float* wlist;
    __device__ bool next(int i, Unit& u) const {
        const long L = (long)i * G + c; if (L >= (long)ntile * 8) return false;
        const int t = (int)(L >> 3), pn = (int)(L & 7); int e = 0;
#pragma unroll
        for (int j = 1; j < 16; ++j) e += (t >= pre[j]) ? 1 : 0;
        const int mt = t - pre[e];
        u.pm = t; u.pn = pn; u.e = e; u.a = A + (size_t)t * a_tstep; u.b = Bt + (size_t)e * b_estep + (size_t)pn * b_tstep;
        u.rows = rowl + e * 8192 + 256 * mt; u.wl = wlist + e * 8192 + 256 * mt; u.nvalid = cnt[e] - 256 * mt; return true;
    }
};

typedef float f32x2_c __attribute__((ext_vector_type(2))); typedef __bf16 bf16x2_c __attribute__((ext_vector_type(2)));
__device__ __forceinline__ unsigned cvt_pk_bf16(float lo, float hi) { const f32x2_c v = {lo, hi}; return __builtin_bit_cast(unsigned, __builtin_convertvector(v, bf16x2_c)); }

struct EpiBf16 {
    static constexpr bool PERM = true;
    bf16_t* O; int ldc;
    __device__ __forceinline__ void operator()(const f32x4 (&acc)[2][2][4][2], const Unit& u, int wr, int wc, int fr, int fq) const {
        const int row0 = u.pm * BM + wr * 64 + fr; const int col0 = u.pn * BM + wc * 32 + 8 * fq;
#pragma unroll
        for (int ai = 0; ai < 2; ++ai)
#pragma unroll
            for (int m = 0; m < 4; ++m) { bf16_t* rowp = O + (size_t)(row0 + ai * HALF + m * 16) * ldc + col0;
#pragma unroll
                for (int bj = 0; bj < 2; ++bj) { const f32x4 v0 = acc[ai][bj][m][0], v1 = acc[ai][bj][m][1];
                    u32x4 w; w.x = cvt_pk_bf16(v0[0], v0[1]); w.y = cvt_pk_bf16(v0[2], v0[3]); w.z = cvt_pk_bf16(v1[0], v1[1]); w.w = cvt_pk_bf16(v1[2], v1[3]);
                    *(u32x4*)(rowp + bj * HALF) = w; } }
    }
};
struct EpiResBf16 {
    static constexpr bool PERM = true;
    const float* base; bf16_t* O; int ldc;
    __device__ __forceinline__ void operator()(const f32x4 (&acc)[2][2][4][2], const Unit& u, int wr, int wc, int fr, int fq) const {
        const int row0 = u.pm * BM + wr * 64 + fr; const int col0 = u.pn * BM + wc * 32 + 8 * fq;
#pragma unroll
        for (int ai = 0; ai < 2; ++ai)
#pragma unroll
            for (int m = 0; m < 4; ++m) { const size_t off = (size_t)(row0 + ai * HALF + m * 16) * ldc + col0;
#pragma unroll
                for (int bj = 0; bj < 2; ++bj) { const f32x4 v0 = acc[ai][bj][m][0] + *(const f32x4*)(base + off + bj * HALF), v1 = acc[ai][bj][m][1] + *(const f32x4*)(base + off + bj * HALF + 4);
                    u32x4 w; w.x = cvt_pk_bf16(v0[0], v0[1]); w.y = cvt_pk_bf16(v0[2], v0[3]); w.z = cvt_pk_bf16(v1[0], v1[1]); w.w = cvt_pk_bf16(v1[2], v1[3]);
                    *(u32x4*)(O + off + bj * HALF) = w; } }
    }
};
__device__ __forceinline__ float silu_f(float v) { return v * __builtin_amdgcn_rcpf(1.f + __builtin_amdgcn_exp2f(-1.4426950408889634f * v)); }
__device__ __forceinline__ unsigned pk4_fp8(float a, float b, float c, float d) { int w = __builtin_amdgcn_cvt_pk_fp8_f32(a, b, 0, false); w = __builtin_amdgcn_cvt_pk_fp8_f32(c, d, w, true); return (unsigned)w; }
struct EpiSwiGlu8 {
    static constexpr bool PERM = true;
    unsigned char* Hid;
    __device__ __forceinline__ void operator()(const f32x4 (&acc)[2][2][4][2], const Unit& u, int wr, int wc, int fr, int fq) const {
        const int row0 = u.pm * BM + wr * 64 + fr; const int col0 = u.pn * HALF + wc * 32 + 8 * fq;
#pragma unroll
        for (int ai = 0; ai < 2; ++ai)
#pragma unroll
            for (int m = 0; m < 4; ++m) { const int row = row0 + ai * HALF + m * 16; const int rl = wr * 64 + fr + ai * HALF + m * 16; const float w = rl < u.nvalid ? 4.f * u.wl[rl] : 0.f;
                const f32x4 g0 = acc[ai][0][m][0], g1 = acc[ai][0][m][1], u0 = acc[ai][1][m][0], u1 = acc[ai][1][m][1];
                float h[8];
#pragma unroll
                for (int j = 0; j < 4; ++j) { h[j] = __builtin_amdgcn_fmed3f(silu_f(g0[j]) * u0[j] * w, -440.f, 440.f); h[4 + j] = __builtin_amdgcn_fmed3f(silu_f(g1[j]) * u1[j] * w, -440.f, 440.f); }
                typedef unsigned u32x2_ __attribute__((ext_vector_type(2)));
                *(u32x2_*)(Hid + (size_t)row * 1024 + col0) = (u32x2_){pk4_fp8(h[0], h[1], h[2], h[3]), pk4_fp8(h[4], h[5], h[6], h[7])}; }
    }
};
struct EpiScatter {
    static constexpr bool PERM = true;
    bf16_t* Y;
    __device__ __forceinline__ void operator()(const f32x4 (&acc)[2][2][4][2], const Unit& u, int wr, int wc, int fr, int fq) const {
        const int row0 = u.pm * BM + wr * 64 + fr; const int col0 = u.pn * BM + wc * 32 + 8 * fq;
#pragma unroll
        for (int ai = 0; ai < 2; ++ai)
#pragma unroll
            for (int m = 0; m < 4; ++m) { const int rl = wr * 64 + fr + ai * HALF + m * 16; const int ri = rl < u.nvalid ? u.rows[rl] : -1;
                if (ri >= 0) { bf16_t* rowp = Y + ((size_t)(ri >> 16) * 8192 + (size_t)(ri & 0xffff)) * 2048 + col0;
#pragma unroll
                    for (int bj = 0; bj < 2; ++bj) { const f32x4 v0 = acc[ai][bj][m][0], v1 = acc[ai][bj][m][1];
                        u32x4 w; w.x = cvt_pk_bf16(v0[0], v0[1]); w.y = cvt_pk_bf16(v0[2], v0[3]); w.z = cvt_pk_bf16(v1[0], v1[1]); w.w = cvt_pk_bf16(v1[2], v1[3]);
                        *(u32x4*)(rowp + bj * HALF) = w; } } }
    }
};

typedef int i32x8 __attribute__((ext_vector_type(8)));
template <class Epi, class Sched, bool FP8 = false, int SCA = 0x7f7f7f7f, int SCB = 0x7f7f7f7f, bool GATHER = false>
__device__ __forceinline__ void gemm_phase(PG8_LAS unsigned char* lds, const int K, const Sched& S, const Epi& E, const PG8_LAS int* rowsL = nullptr) {
    const int tid = threadIdx.x, wid = __builtin_amdgcn_readfirstlane(tid >> 6), lane = tid & 63, wr = wid >> 2, wc = wid & 3, fr = lane & 15, fq = lane >> 4;
    const int Kb = FP8 ? K : 2 * K;
    const int nt = Kb / (BK * 2);
    unsigned voffA[2], voffB[2], CA[2]; int RA[2];
#pragma unroll
    for (int i = 0; i < 2; ++i) { int R, C; stage_rc(tid * 16 + i * 8192, R, C); const int Rb = Epi::PERM ? ((R & ~31) + perm32(R & 31)) : R;
        voffA[i] = (unsigned)(R * Kb + C * 2); voffB[i] = (unsigned)(Rb * Kb + C * 2); RA[i] = R; CA[i] = (unsigned)(C * 2); }
    unsigned vA0[2] = {0u, 0u}, vA1[2] = {0u, 0u}, vN0[2] = {0u, 0u}, vN1[2] = {0u, 0u};
#define PG8_ROWS(v0, v1, u_) do { _Pragma("unroll") for (int i_ = 0; i_ < 2; ++i_) { v0[i_] = (unsigned)rowsL[(u_) * 256 + RA[i_]] * (unsigned)Kb + CA[i_]; v1[i_] = (unsigned)rowsL[(u_) * 256 + 128 + RA[i_]] * (unsigned)Kb + CA[i_]; } } while (0)
#define PG8_STAGE_A(bufoff, gbase, h) do { if constexpr (GATHER) { if (h) PG8_STAGE(bufoff, gbase, vA1); else PG8_STAGE(bufoff, gbase, vA0); } else { PG8_STAGE(bufoff, (gbase) + (h) * hstep, voffA); } } while (0)
    const size_t kstep = (size_t)(BK * 2);
    const size_t hstep = (size_t)HALF * Kb;
    const unsigned ldsw = (unsigned)wid * 1024u;
    const int aoff0 = lds_chunk(wr * 64 + fr, fq), aoff1 = lds_chunk(wr * 64 + fr, 4 + fq), boff0 = lds_chunk(wc * 32 + fr, fq), boff1 = lds_chunk(wc * 32 + fr, 4 + fq);
#define PG8_SA(b, h) (((b) * 2 + (h)) * HTB)
#define PG8_SB(b, h) ((4 + (b) * 2 + (h)) * HTB)
#define PG8_STAGE(bufoff, gbase, voff) do { _Pragma("unroll") for (int _i = 0; _i < 2; ++_i) \
        __builtin_amdgcn_global_load_lds((const unsigned*)((const char*)(gbase) + (voff)[_i]), (PG8_LAS unsigned*)(lds + (bufoff) + ldsw + _i * 8192), 16, 0, 0); } while (0)
#define PG8_LD32(p0, p1) __builtin_shufflevector(*(const PG8_LAS u32x4*)(p0), *(const PG8_LAS u32x4*)(p1), 0, 1, 2, 3, 4, 5, 6, 7)
#define PG8_LDA(dst, b, h) do { if constexpr (FP8) { _Pragma("unroll") for (int m = 0; m < 4; ++m) dst##8[m] = __builtin_bit_cast(i32x8, PG8_LD32(lds + PG8_SA(b, h) + aoff0 + m * 2048, lds + PG8_SA(b, h) + aoff1 + m * 2048)); } \
        else { _Pragma("unroll") for (int m = 0; m < 4; ++m) { dst[m][0] = *(const PG8_LAS bf16x8*)(lds + PG8_SA(b, h) + aoff0 + m * 2048); dst[m][1] = *(const PG8_LAS bf16x8*)(lds + PG8_SA(b, h) + aoff1 + m * 2048); } } } while (0)
#define PG8_LDB(dst, b, h) do { if constexpr (FP8) { _Pragma("unroll") for (int n = 0; n < 2; ++n) dst##8[n] = __builtin_bit_cast(i32x8, PG8_LD32(lds + PG8_SB(b, h) + boff0 + n * 2048, lds + PG8_SB(b, h) + boff1 + n * 2048)); } \
        else { _Pragma("unroll") for (int n = 0; n < 2; ++n) { dst[n][0] = *(const PG8_LAS bf16x8*)(lds + PG8_SB(b, h) + boff0 + n * 2048); dst[n][1] = *(const PG8_LAS bf16x8*)(lds + PG8_SB(b, h) + boff1 + n * 2048); } } } while (0)
#define PG8_CAT8(x) __builtin_shufflevector(__builtin_bit_cast(u32x4, (x)[0]), __builtin_bit_cast(u32x4, (x)[1]), 0, 1, 2, 3, 4, 5, 6, 7)
#define PG8_MMA(ai, bj, At, Bt) do { __builtin_amdgcn_s_setprio(1); \
        if constexpr (FP8) { _Pragma("unroll") for (int m = 0; m < 4; ++m) _Pragma("unroll") for (int n = 0; n < 2; ++n) \
            asm volatile("s_nop 1\n\tv_mfma_scale_f32_16x16x128_f8f6f4 %0, %1, %2, %0, %3, %4 op_sel_hi:[0,0,0]" : "+v"(acc[ai][bj][m][n]) : "v"(Bt##8[n]), "v"(At##8[m]), "v"(scb_), "v"(sca_)); } \
        else { _Pragma("unroll") for (int m = 0; m < 4; ++m) _Pragma("unroll") for (int n = 0; n < 2; ++n) _Pragma("unroll") for (int k = 0; k < 2; ++k) \
            acc[ai][bj][m][n] = __builtin_amdgcn_mfma_f32_16x16x32_bf16(Bt[n][k], At[m][k], acc[ai][bj][m][n], 0, 0, 0); } \
        __builtin_amdgcn_s_setprio(0); } while (0)
#define PG8_WAIT_V(n) asm volatile("s_waitcnt vmcnt(" #n ")" ::: "memory")
#define PG8_WAIT_L(n) asm volatile("s_waitcnt lgkmcnt(" #n ")" ::: "memory")
#define PG8_BAR __builtin_amdgcn_s_barrier()
#define PG8_SCHED __builtin_amdgcn_sched_barrier(0)
    int sca_ = SCA, scb_ = SCB; asm volatile("" : "+v"(sca_), "+v"(scb_));
    Unit cur, nxt; int ui = 0;
    if (!S.next(0, cur)) return;
    f32x4 acc[2][2][4][2];
#pragma unroll
    for (int a = 0; a < 2; ++a)
#pragma unroll
        for (int b = 0; b < 2; ++b)
#pragma unroll
            for (int m = 0; m < 4; ++m)
#pragma unroll
                for (int n = 0; n < 2; ++n) acc[a][b][m][n] = (f32x4){0.f, 0.f, 0.f, 0.f};
    bf16x8 At[4][2], B0[2][2], B1[2][2]; i32x8 At8[4], B08[2], B18[2];
    const char* cA = cur.a; const char* cB = cur.b;
    if constexpr (GATHER) { PG8_ROWS(vA0, vA1, 0); }
    PG8_STAGE(PG8_SB(0, 0), cB, voffB); PG8_STAGE(PG8_SB(0, 1), cB + hstep, voffB); PG8_STAGE_A(PG8_SA(0, 0), cA, 0); PG8_STAGE_A(PG8_SA(0, 1), cA, 1);
    if (wr == 1) PG8_BAR;
    PG8_WAIT_V(2); PG8_BAR;
    PG8_STAGE(PG8_SB(1, 0), cB + kstep, voffB); PG8_STAGE_A(PG8_SA(1, 0), cA + kstep, 0); PG8_STAGE(PG8_SB(1, 1), cB + hstep + kstep, voffB);
    PG8_WAIT_V(6); PG8_BAR;
    for (;;) {
        const bool has_next = S.next(ui + 1, nxt);
        const char* nA = has_next ? nxt.a : cA; const char* nB = has_next ? nxt.b : cB;
        if constexpr (GATHER) { PG8_ROWS(vN0, vN1, has_next ? ui + 1 : ui); }
#pragma clang loop unroll(disable)
        for (int t = 0; t < nt; t += 2) {
            const bool last = (t == nt - 2);
            const char* a1 = cA + (size_t)(t + 1) * kstep;
            const char* a2 = last ? nA : cA + (size_t)(t + 2) * kstep; const char* b2 = last ? nB : cB + (size_t)(t + 2) * kstep;
            const char* a3 = a2 + kstep; const char* b3 = b2 + kstep;
            PG8_LDB(B0, 0, 0); PG8_LDB(B1, 0, 1); PG8_SCHED; PG8_LDA(At, 0, 0); PG8_STAGE_A(PG8_SA(1, 1), a1, 1);
            if constexpr (GATHER) { if (last) { vA0[0] = vN0[0]; vA0[1] = vN0[1]; vA1[0] = vN1[0]; vA1[1] = vN1[1]; } }
            PG8_WAIT_V(8); PG8_WAIT_L(0); PG8_BAR; PG8_MMA(0, 0, At, B0); PG8_MMA(0, 1, At, B1); PG8_BAR; PG8_SCHED;
            PG8_LDA(At, 0, 1); PG8_STAGE(PG8_SB(0, 0), b2, voffB); PG8_STAGE(PG8_SB(0, 1), b2 + hstep, voffB); PG8_STAGE_A(PG8_SA(0, 0), a2, 0);
            PG8_WAIT_V(8); PG8_WAIT_L(0); PG8_BAR; PG8_MMA(1, 0, At, B0); PG8_MMA(1, 1, At, B1); PG8_BAR; PG8_SCHED;
            PG8_LDB(B0, 1, 0); PG8_LDB(B1, 1, 1); PG8_SCHED; PG8_LDA(At, 1, 0); PG8_STAGE_A(PG8_SA(0, 1), a2, 1);
            PG8_WAIT_V(8); PG8_WAIT_L(0); PG8_BAR; PG8_MMA(0, 0, At, B0); PG8_MMA(0, 1, At, B1); PG8_BAR; PG8_SCHED;
            PG8_LDA(At, 1, 1); PG8_STAGE(PG8_SB(1, 0), b3, voffB); PG8_STAGE(PG8_SB(1, 1), b3 + hstep, voffB); PG8_STAGE_A(PG8_SA(1, 0), a3, 0);
            PG8_WAIT_V(8); PG8_WAIT_L(0); PG8_BAR; PG8_MMA(1, 0, At, B0); PG8_MMA(1, 1, At, B1); PG8_BAR; PG8_SCHED;
        }
        if (wr == 0) PG8_BAR;
        if constexpr (FP8) asm volatile("s_nop 15\n\ts_nop 15" ::: "memory");
        E(acc, cur, wr, wc, fr, fq);
        if (!has_next) break;
#pragma unroll
        for (int a = 0; a < 2; ++a)
#pragma unroll
            for (int b = 0; b < 2; ++b)
#pragma unroll
                for (int m = 0; m < 4; ++m)
#pragma unroll
                    for (int n = 0; n < 2; ++n) acc[a][b][m][n] = (f32x4){0.f, 0.f, 0.f, 0.f};
        cur = nxt; cA = nA; cB = nB; ++ui;
        if (wr == 1) PG8_BAR;
    }
    PG8_WAIT_V(0);
    PG8_BAR;
#undef PG8_SA
#undef PG8_SB
#undef PG8_STAGE
#undef PG8_STAGE_A
#undef PG8_ROWS
#undef PG8_LDA
#undef PG8_LD32
#undef PG8_LDB
#undef PG8_MMA
#undef PG8_CAT8
#undef PG8_WAIT_V
#undef PG8_WAIT_L
#undef PG8_BAR
#undef PG8_SCHED
}
}

namespace moba {
typedef short bf16x8 __attribute__((ext_vector_type(8)));
typedef short s16x4 __attribute__((ext_vector_type(4)));
typedef float f32x16 __attribute__((ext_vector_type(16)));
typedef float f32x4 __attribute__((ext_vector_type(4)));
typedef unsigned u32x4 __attribute__((ext_vector_type(4)));
typedef unsigned short bf16;
constexpr int NW = 8, QBLK = 32, KVBLK = 64, QB = NW * QBLK, D = 128;
constexpr int SHM_V = KVBLK * D * 2, SHM_K = KVBLK * D * 2;
constexpr int LDS_WS = 2 * SHM_V + 2 * SHM_K, LDS_KM = LDS_WS + NW * 64 * 4, LDS_END = LDS_KM + 8 * 128 * 4;
constexpr float SCALE = 0.08838834764831845f, THR = 8.f;
constexpr int QP = 7168, OP = 2048;
#define KSWZ(row, colB) ((row) * 256 + ((colB) ^ (((row) & 7) << 4)))
#define SBAR() __builtin_amdgcn_sched_barrier(0)
__device__ __forceinline__ int v_st(int k, int c) { const int kk = (k & ~0xC) | ((k & 4) << 1) | ((k & 8) >> 1); return ((kk >> 3) * 4 + (c >> 5)) * 512 + ((kk & 7) * 32 + (c & 31)) * 2; }
__device__ __forceinline__ int v_rd_base(int lane) { return ((lane & 3) << 3) | (((lane >> 2) & 3) << 6) | (((lane >> 4) & 1) << 5) | (((lane >> 5) & 1) << 8); }
constexpr int v_rd_off(int d0, int ks, int half) { return d0 * 512 + ks * 4096 + half * 2048; }
__device__ __forceinline__ int crow(int r, int hi) { return (r & 3) + 8 * (r >> 2) + 4 * hi; }
typedef float f32x2_m __attribute__((ext_vector_type(2))); typedef __bf16 bf16x2_m __attribute__((ext_vector_type(2)));
__device__ __forceinline__ unsigned cvtpk(float lo, float hi) { const f32x2_m v = {lo, hi}; return __builtin_bit_cast(unsigned, __builtin_convertvector(v, bf16x2_m)); }
__device__ __forceinline__ bf16x8 load8(const bf16* p) { return *reinterpret_cast<const bf16x8*>(p); }
__device__ __forceinline__ void mask_tile(f32x16& p0, f32x16& p1, int dq) {
    const float NEG = -__builtin_inff();
#pragma unroll
    for (int r = 0; r < 16; ++r) { const int c = (r & 3) + 8 * (r >> 2); if (dq - c < 0) p0[r] = NEG; if (dq - c - 32 < 0) p1[r] = NEG; }
}
__device__ __forceinline__ void partialSM(f32x16& p0, f32x16& p1, float& m_reg, float& mn, float& alpha) {
    float pmax = p0[0]; for (int r = 1; r < 16; ++r) pmax = fmaxf(pmax, p0[r]); for (int r = 0; r < 16; ++r) pmax = fmaxf(pmax, p1[r]);
    { auto rr = __builtin_amdgcn_permlane32_swap(__float_as_uint(pmax), __float_as_uint(pmax), false, false);
      pmax = fmaxf(__uint_as_float(rr[0]), __uint_as_float(rr[1])); }
    constexpr float C2 = 1.4426950408889634f * SCALE;
    if (__builtin_expect(__all((pmax - m_reg) * SCALE <= THR), 1)) { mn = m_reg; alpha = 1.f; }
    else { mn = fmaxf(m_reg, pmax); alpha = __builtin_amdgcn_exp2f((m_reg - mn) * C2); m_reg = mn; }
    const float mnL = -mn * C2;
    for (int r = 0; r < 16; ++r) p0[r] = fmaf(p0[r], C2, mnL); for (int r = 0; r < 16; ++r) p1[r] = fmaf(p1[r], C2, mnL);
    for (int r = 0; r < 16; ++r) p0[r] = __builtin_amdgcn_exp2f(p0[r]);
}
__device__ __forceinline__ void finishSM(f32x16& p0, f32x16& p1, float alpha, float& l_reg, bf16x8& pa0, bf16x8& pa1, bf16x8& pa2, bf16x8& pa3) {
    for (int r = 0; r < 16; ++r) p1[r] = __builtin_amdgcn_exp2f(p1[r]);
    float ps = 0; for (int r = 0; r < 16; ++r) ps += p0[r]; for (int r = 0; r < 16; ++r) ps += p1[r];
    { auto rr = __builtin_amdgcn_permlane32_swap(__float_as_uint(ps), __float_as_uint(ps), false, false);
      ps = __uint_as_float(rr[0]) + __uint_as_float(rr[1]); }
    l_reg = l_reg * alpha + ps;
#define PK4(P, B_, OUT) do { unsigned a0 = cvtpk(P[B_+0], P[B_+1]), a1 = cvtpk(P[B_+2], P[B_+3]);                          \
        unsigned b0 = cvtpk(P[B_+4], P[B_+5]), b1 = cvtpk(P[B_+6], P[B_+7]);                                             \
        auto r0 = __builtin_amdgcn_permlane32_swap(a0, b0, false, false); auto r1 = __builtin_amdgcn_permlane32_swap(a1, b1, false, false); \
        u32x4 w = {r0[0], r1[0], r0[1], r1[1]}; OUT = *reinterpret_cast<bf16x8*>(&w); } while (0)
    PK4(p0, 0, pa0); PK4(p0, 8, pa1); PK4(p1, 0, pa2); PK4(p1, 8, pa3);
#undef PK4
}
template <int KB>
__device__ __forceinline__ void qkt(f32x16& p0, f32x16& p1, const char* K_lds, int r32, int hi, const bf16x8* qr, float base, float beta) {
    { const float b1 = beta, b2 = beta + beta, b3 = b2 + beta, b8 = 8.f * beta, b32 = 32.f * beta;
      p0[0] = base; p0[1] = base + b1; p0[2] = base + b2; p0[3] = base + b3;
#pragma unroll
      for (int r = 4; r < 16; ++r) p0[r] = p0[r - 4] + b8;
#pragma unroll
      for (int r = 0; r < 16; ++r) p1[r] = p0[r] + b32; }
    const char* kb[4];
#pragma unroll
    for (int dd = 0; dd < 4; ++dd) kb[dd] = K_lds + KB * SHM_K + KSWZ(r32, (dd * 16 + hi * 8) * 2);
#pragma unroll
    for (int d0 = 0; d0 < 8; ++d0) { const char* a = kb[d0 & 3] + (d0 >> 2) * 128;
        bf16x8 b0 = *reinterpret_cast<const bf16x8*>(a);
        bf16x8 b1 = *reinterpret_cast<const bf16x8*>(a + 32 * 256);
        p0 = __builtin_amdgcn_mfma_f32_32x32x16_bf16(b0, qr[d0], p0, 0, 0, 0);
        p1 = __builtin_amdgcn_mfma_f32_32x32x16_bf16(b1, qr[d0], p1, 0, 0, 0); }
}
template <int VB>
__device__ __forceinline__ void pv_tile(f32x16* o, int vb0, bf16x8 pa0, bf16x8 pa1, bf16x8 pa2, bf16x8 pa3) {
#define TRRD(dst, off) asm volatile("ds_read_b64_tr_b16 %0, %1 offset:%2" : "=&v"(dst) : "v"(vb0), "i"(off) : "memory")
#define PV_D0(d0) do { s16x4 l0, l1, l2, l3, h0, h1, h2, h3; constexpr int b_ = VB * SHM_V + v_rd_off(d0, 0, 0); \
        TRRD(l0, b_); TRRD(h0, b_ + 2048); TRRD(l1, b_ + 4096); TRRD(h1, b_ + 6144); TRRD(l2, b_ + 8192); TRRD(h2, b_ + 10240); TRRD(l3, b_ + 12288); TRRD(h3, b_ + 14336); \
        asm volatile("s_waitcnt lgkmcnt(0)" ::: "memory"); SBAR();   \
        o[d0] = __builtin_amdgcn_mfma_f32_32x32x16_bf16(pa0, (bf16x8){l0[0], l0[1], l0[2], l0[3], h0[0], h0[1], h0[2], h0[3]}, o[d0], 0, 0, 0);   \
        o[d0] = __builtin_amdgcn_mfma_f32_32x32x16_bf16(pa1, (bf16x8){l1[0], l1[1], l1[2], l1[3], h1[0], h1[1], h1[2], h1[3]}, o[d0], 0, 0, 0);   \
        o[d0] = __builtin_amdgcn_mfma_f32_32x32x16_bf16(pa2, (bf16x8){l2[0], l2[1], l2[2], l2[3], h2[0], h2[1], h2[2], h2[3]}, o[d0], 0, 0, 0);   \
        o[d0] = __builtin_amdgcn_mfma_f32_32x32x16_bf16(pa3, (bf16x8){l3[0], l3[1], l3[2], l3[3], h3[0], h3[1], h3[2], h3[3]}, o[d0], 0, 0, 0); } while (0)
    PV_D0(0); PV_D0(1); PV_D0(2); PV_D0(3);
#undef PV_D0
#undef TRRD
}
constexpr int R_V = 0, R_K = 3 * SHM_V, R_WS = R_K + 3 * SHM_K, R_KM = R_WS + NW * 64 * 4, R_END = R_KM + 8 * 128 * 4;
__device__ __forceinline__ void qkt_r(f32x16& p0, f32x16& p1, const char* Kslot, int r32, int hi, const bf16x8* qr, float base, float beta) {
    { const float b1 = beta, b2 = beta + beta, b3 = b2 + beta, b8 = 8.f * beta, b32 = 32.f * beta;
      p0[0] = base; p0[1] = base + b1; p0[2] = base + b2; p0[3] = base + b3;
#pragma unroll
      for (int r = 4; r < 16; ++r) p0[r] = p0[r - 4] + b8;
#pragma unroll
      for (int r = 0; r < 16; ++r) p1[r] = p0[r] + b32; }
    const char* kb[4];
#pragma unroll
    for (int dd = 0; dd < 4; ++dd) kb[dd] = Kslot + KSWZ(r32, (dd * 16 + hi * 8) * 2);
#pragma unroll
    for (int d0 = 0; d0 < 8; ++d0) { const char* a = kb[d0 & 3] + (d0 >> 2) * 128;
        bf16x8 b0 = *reinterpret_cast<const bf16x8*>(a);
        bf16x8 b1 = *reinterpret_cast<const bf16x8*>(a + 32 * 256);
        p0 = __builtin_amdgcn_mfma_f32_32x32x16_bf16(b0, qr[d0], p0, 0, 0, 0);
        p1 = __builtin_amdgcn_mfma_f32_32x32x16_bf16(b1, qr[d0], p1, 0, 0, 0); }
}
__device__ __forceinline__ void pv_tile_r(f32x16* o, int vbs  , bf16x8 pa0, bf16x8 pa1, bf16x8 pa2, bf16x8 pa3) {
#define TRRD(dst, off) asm volatile("ds_read_b64_tr_b16 %0, %1 offset:%2" : "=&v"(dst) : "v"(vbs), "i"(off) : "memory")
#define PV_D0(d0) do { s16x4 l0, l1, l2, l3, h0, h1, h2, h3; constexpr int b_ = v_rd_off(d0, 0, 0); \
        TRRD(l0, b_); TRRD(h0, b_ + 2048); TRRD(l1, b_ + 4096); TRRD(h1, b_ + 6144); TRRD(l2, b_ + 8192); TRRD(h2, b_ + 10240); TRRD(l3, b_ + 12288); TRRD(h3, b_ + 14336); \
        asm volatile("s_waitcnt lgkmcnt(0)" ::: "memory"); SBAR();   \
        o[d0] = __builtin_amdgcn_mfma_f32_32x32x16_bf16(pa0, (bf16x8){l0[0], l0[1], l0[2], l0[3], h0[0], h0[1], h0[2], h0[3]}, o[d0], 0, 0, 0);   \
        o[d0] = __builtin_amdgcn_mfma_f32_32x32x16_bf16(pa1, (bf16x8){l1[0], l1[1], l1[2], l1[3], h1[0], h1[1], h1[2], h1[3]}, o[d0], 0, 0, 0);   \
        o[d0] = __builtin_amdgcn_mfma_f32_32x32x16_bf16(pa2, (bf16x8){l2[0], l2[1], l2[2], l2[3], h2[0], h2[1], h2[2], h2[3]}, o[d0], 0, 0, 0);   \
        o[d0] = __builtin_amdgcn_mfma_f32_32x32x16_bf16(pa3, (bf16x8){l3[0], l3[1], l3[2], l3[3], h3[0], h3[1], h3[2], h3[3]}, o[d0], 0, 0, 0); } while (0)
    PV_D0(0); PV_D0(1); PV_D0(2); PV_D0(3);
#undef PV_D0
#undef TRRD
}
__device__ __forceinline__ void moba_unit_ring(const bf16* Q, const bf16* Kh, const bf16* Vh, bf16* O, int qb, float beta, char* lds) {
    int tid = threadIdx.x; asm volatile("" : "+v"(tid));
    const int wid = __builtin_amdgcn_readfirstlane(tid >> 6), lane = tid & 63, r32 = lane & 31, hi = lane >> 5;
    char* V_lds = lds + R_V; char* K_lds = lds + R_K;
    float* ws = (float*)(lds + R_WS) + wid * 64; float* al_l = ws + 32;
    float* km = (float*)(lds + R_KM);
    const int P0 = qb * QB, NT = 4 * (qb + 1);
    const int sr = tid >> 4, sc = (tid & 15) * 8, vst0 = v_st(sr, sc), vst1 = v_st(32 + sr, sc), kws = KSWZ(sr, sc * 2);
    const int vb0 = (int)(uintptr_t)V_lds + v_rd_base(lane);
    bf16x8 qr[8]; bf16x8 st_v0, st_v1, st_k0, st_k1;
#define ROW(p, k0, rr) ((p) + (size_t)((k0) + (rr)) * QP + sc)
#define VMW() asm volatile("s_waitcnt vmcnt(0)" ::: "memory")
#define SLOAD_H(k0) do { st_v0 = load8(ROW(Vh, k0, sr)); st_v1 = load8(ROW(Vh, k0, 32 + sr)); st_k0 = load8(ROW(Kh, k0, sr)); st_k1 = load8(ROW(Kh, k0, 32 + sr)); } while (0)
#define SWRITE_R(off) do { *(bf16x8*)(V_lds + (off) + vst0) = st_v0; *(bf16x8*)(V_lds + (off) + vst1) = st_v1; *(bf16x8*)(K_lds + (off) + kws) = st_k0; *(bf16x8*)(K_lds + (off) + kws + 32 * 256) = st_k1; } while (0)
    __syncthreads();
    if (wid < qb) { float s0 = 0.f, s1 = 0.f; const bf16* kp = Kh + (size_t)(wid * 256) * QP + 2 * lane;
#pragma unroll 8
        for (int j = 0; j < 256; ++j) { const unsigned w = *(const unsigned*)(kp + (size_t)j * QP); s0 += __uint_as_float(w << 16); s1 += __uint_as_float(w & 0xffff0000u); }
        km[wid * 128 + 2 * lane] = s0 * (1.f / 256.f); km[wid * 128 + 2 * lane + 1] = s1 * (1.f / 256.f); }
#pragma unroll
    for (int d0 = 0; d0 < 8; ++d0) qr[d0] = load8(Q + (size_t)(P0 + wid * QBLK + r32) * QP + d0 * 16 + hi * 8);
    SLOAD_H(0); VMW(); SWRITE_R(0);
    SLOAD_H(KVBLK);
    __syncthreads();
    unsigned selbits = (1u << qb) - 1u;
    if (qb > 3) { float gt[8];
#pragma unroll
        for (int n = 0; n < 8; ++n) { float a = 0.f;
            if (n < qb) {
#pragma unroll
                for (int d0 = 0; d0 < 8; ++d0) { const f32x4 k0 = *(const f32x4*)(km + n * 128 + d0 * 16 + hi * 8), k1 = *(const f32x4*)(km + n * 128 + d0 * 16 + hi * 8 + 4); const bf16x8 q = qr[d0];
                    a += __uint_as_float((unsigned)(unsigned short)q[0] << 16) * k0[0] + __uint_as_float((unsigned)(unsigned short)q[1] << 16) * k0[1] + __uint_as_float((unsigned)(unsigned short)q[2] << 16) * k0[2] + __uint_as_float((unsigned)(unsigned short)q[3] << 16) * k0[3]
                       + __uint_as_float((unsigned)(unsigned short)q[4] << 16) * k1[0] + __uint_as_float((unsigned)(unsigned short)q[5] << 16) * k1[1] + __uint_as_float((unsigned)(unsigned short)q[6] << 16) * k1[2] + __uint_as_float((unsigned)(unsigned short)q[7] << 16) * k1[3]; }
                a += __shfl_xor(a, 32); }
            gt[n] = (n < qb) ? a : -__builtin_inff(); }
        selbits = 0u;
#pragma unroll
        for (int k = 0; k < 3; ++k) { float best = -__builtin_inff(); int bi = 0;
#pragma unroll
            for (int n = 0; n < 8; ++n) { const bool take = !((selbits >> n) & 1u) && gt[n] > best; best = take ? gt[n] : best; bi = take ? n : bi; }
            selbits |= 1u << bi; } }
    selbits |= 1u << qb;
    const int qlo = P0 + wid * QBLK, qm = qlo + r32 - 4 * hi;
    float m_reg = -1e30f, l_reg = 0; f32x16 o[4] = {};
#define RESC(a) do { if (__any((a) < 1.f)) { if (hi == 0) al_l[r32] = (a); asm volatile("s_waitcnt lgkmcnt(0)" ::: "memory");              \
                     for (int d_ = 0; d_ < 4; ++d_) for (int r = 0; r < 16; ++r) o[d_][r] *= al_l[crow(r, hi)]; } } while (0)
#define KBASE(t) ((t) * KVBLK)
#define BASE(t) (((selbits >> ((t) >> 2)) & 1u) ? beta * (float)(KBASE(t) - P0 + 4 * hi) : -__builtin_inff())
#define MASKT(P0_, P1_, t) do { const int kb_ = KBASE(t); if (kb_ + KVBLK - 1 > qlo) mask_tile(P0_, P1_, qm - kb_); } while (0)
    f32x16 pA0, pA1, pB0, pB1; float mnA, mnB, alA, alB; bf16x8 pa0, pa1, pa2, pa3;
    int s_prv = 2 * SHM_K, s_cur = 0, s_nxt = SHM_K;
#define ROT() do { const int o_ = s_prv; s_prv = s_cur; s_cur = s_nxt; s_nxt = o_; } while (0)
    SBAR(); qkt_r(pA0, pA1, K_lds + s_cur, r32, hi, qr, BASE(0), beta);
    VMW(); SWRITE_R(s_nxt); SBAR(); SLOAD_H(KBASE(2)); SBAR();
    MASKT(pA0, pA1, 0); partialSM(pA0, pA1, m_reg, mnA, alA); RESC(alA);
    __syncthreads(); ROT();
#define STEP(PX0, PX1, mnX, alX, PY0, PY1, alY, t) do {                                                                         \
        SBAR(); qkt_r(PX0, PX1, K_lds + s_cur, r32, hi, qr, BASE(t), beta);                                                     \
        finishSM(PY0, PY1, alY, l_reg, pa0, pa1, pa2, pa3); SBAR();                                                             \
        if ((t) + 1 < NT) { VMW(); SWRITE_R(s_nxt); SBAR(); if ((t) + 2 < NT) { SLOAD_H(KBASE((t) + 2)); SBAR(); } }            \
        pv_tile_r(o, vb0 + s_prv, pa0, pa1, pa2, pa3); MASKT(PX0, PX1, (t)); partialSM(PX0, PX1, m_reg, mnX, alX);              \
        RESC(alX); __syncthreads(); ROT(); } while (0)
    for (int t = 1; t + 1 < NT; t += 2) {
        STEP(pB0, pB1, mnB, alB, pA0, pA1, alA, t);
        STEP(pA0, pA1, mnA, alA, pB0, pB1, alB, t + 1);
    }
    STEP(pB0, pB1, mnB, alB, pA0, pA1, alA, NT - 1);
    finishSM(pB0, pB1, alB, l_reg, pa0, pa1, pa2, pa3); SBAR(); pv_tile_r(o, vb0 + s_prv, pa0, pa1, pa2, pa3);
    { int t2 = threadIdx.x; asm volatile("" : "+v"(t2)); const int r32e = t2 & 31, hie = (t2 >> 5) & 1;
      float* wse = (float*)(lds + R_WS) + wid * 64;
      if (hie == 0) wse[r32e] = l_reg; asm volatile("s_waitcnt lgkmcnt(0)" ::: "memory");
      bf16* Ow = O + (size_t)(P0 + wid * QBLK) * OP + r32e;
#pragma unroll
      for (int r = 0; r < 16; ++r) { const int orow = crow(r, hie); const float rl = __builtin_amdgcn_rcpf(wse[orow]);
#pragma unroll
        for (int d0 = 0; d0 < 4; ++d0) { const float v = o[d0][r] * rl; const float vn = __shfl_xor(v, 1);
            if ((r32e & 1) == 0) *(unsigned*)(Ow + (size_t)orow * OP + d0 * 32) = cvtpk(v, vn); } } }
#undef RESC
#undef KBASE
#undef BASE
#undef MASKT
#undef STEP
#undef ROT
#undef ROW
#undef VMW
#undef SLOAD_H
#undef SWRITE_R
}
__device__ __forceinline__ void moba_unit(const bf16* Q, const bf16* Kh, const bf16* Vh, bf16* O, int qb, float beta, char* lds) {
    int tid = threadIdx.x; asm volatile("" : "+v"(tid));
    const int wid = __builtin_amdgcn_readfirstlane(tid >> 6), lane = tid & 63, r32 = lane & 31, hi = lane >> 5;
    char* V_lds = lds; char* K_lds = lds + 2 * SHM_V;
    float* ws = (float*)(lds + LDS_WS) + wid * 64; float* li_l = ws, * al_l = ws + 32;
    float* km = (float*)(lds + LDS_KM);
    const int P0 = qb * QB, NT = 4 * (qb + 1);
    const int sr = tid >> 4, sc = (tid & 15) * 8, vst0 = v_st(sr, sc), vst1 = v_st(32 + sr, sc), kws = KSWZ(sr, sc * 2);
    const int vb0 = (int)(uintptr_t)V_lds + v_rd_base(lane);
    bf16x8 qr[8]; bf16x8 st_v0, st_v1, st_k0, st_k1;
#define ROW(p, k0, rr) ((p) + (size_t)((k0) + (rr)) * QP + sc)
#define VMW() asm volatile("s_waitcnt vmcnt(0)" ::: "memory")
#define SLOAD_H(k0) do { st_v0 = load8(ROW(Vh, k0, sr)); st_v1 = load8(ROW(Vh, k0, 32 + sr)); st_k0 = load8(ROW(Kh, k0, sr)); st_k1 = load8(ROW(Kh, k0, 32 + sr)); } while (0)
#define SWRITE_HK(bf) do { *(bf16x8*)(K_lds + (bf) * SHM_K + kws) = st_k0; *(bf16x8*)(K_lds + (bf) * SHM_K + kws + 32 * 256) = st_k1; } while (0)
#define SWRITE_HV(bf) do { *(bf16x8*)(V_lds + (bf) * SHM_V + vst0) = st_v0; *(bf16x8*)(V_lds + (bf) * SHM_V + vst1) = st_v1; } while (0)
#define SWRITE_H(bf) do { SWRITE_HV(bf); SWRITE_HK(bf); } while (0)
    __syncthreads();
    if (wid < qb) { float s0 = 0.f, s1 = 0.f; const bf16* kp = Kh + (size_t)(wid * 256) * QP + 2 * lane;
#pragma unroll 8
        for (int j = 0; j < 256; ++j) { const unsigned w = *(const unsigned*)(kp + (size_t)j * QP); s0 += __uint_as_float(w << 16); s1 += __uint_as_float(w & 0xffff0000u); }
        km[wid * 128 + 2 * lane] = s0 * (1.f / 256.f); km[wid * 128 + 2 * lane + 1] = s1 * (1.f / 256.f); }
#pragma unroll
    for (int d0 = 0; d0 < 8; ++d0) qr[d0] = load8(Q + (size_t)(P0 + wid * QBLK + r32) * QP + d0 * 16 + hi * 8);
    SLOAD_H(0); VMW(); SWRITE_HK(0);
    __syncthreads();
    unsigned selbits = (1u << qb) - 1u;
    if (qb > 3) { float gt[8];
#pragma unroll
        for (int n = 0; n < 8; ++n) { float a = 0.f;
            if (n < qb) {
#pragma unroll
                for (int d0 = 0; d0 < 8; ++d0) { const f32x4 k0 = *(const f32x4*)(km + n * 128 + d0 * 16 + hi * 8), k1 = *(const f32x4*)(km + n * 128 + d0 * 16 + hi * 8 + 4); const bf16x8 q = qr[d0];
                    a += __uint_as_float((unsigned)(unsigned short)q[0] << 16) * k0[0] + __uint_as_float((unsigned)(unsigned short)q[1] << 16) * k0[1] + __uint_as_float((unsigned)(unsigned short)q[2] << 16) * k0[2] + __uint_as_float((unsigned)(unsigned short)q[3] << 16) * k0[3]
                       + __uint_as_float((unsigned)(unsigned short)q[4] << 16) * k1[0] + __uint_as_float((unsigned)(unsigned short)q[5] << 16) * k1[1] + __uint_as_float((unsigned)(unsigned short)q[6] << 16) * k1[2] + __uint_as_float((unsigned)(unsigned short)q[7] << 16) * k1[3]; }
                a += __shfl_xor(a, 32); }
            gt[n] = (n < qb) ? a : -__builtin_inff(); }
        selbits = 0u;
#pragma unroll
        for (int k = 0; k < 3; ++k) { float best = -__builtin_inff(); int bi = 0;
#pragma unroll
            for (int n = 0; n < 8; ++n) { const bool take = !((selbits >> n) & 1u) && gt[n] > best; best = take ? gt[n] : best; bi = take ? n : bi; }
            selbits |= 1u << bi; } }
    selbits |= 1u << qb;
    const int qlo = P0 + wid * QBLK, qm = qlo + r32 - 4 * hi;
    float m_reg = -1e30f, l_reg = 0; f32x16 o[4] = {};
#define RESC(a) do { if (__any((a) < 1.f)) { if (hi == 0) al_l[r32] = (a); asm volatile("s_waitcnt lgkmcnt(0)" ::: "memory");              \
                     for (int d_ = 0; d_ < 4; ++d_) for (int r = 0; r < 16; ++r) o[d_][r] *= al_l[crow(r, hi)]; } } while (0)
#define KBASE(t) ((t) * KVBLK)
#define BASE(t) (((selbits >> ((t) >> 2)) & 1u) ? beta * (float)(KBASE(t) - P0 + 4 * hi) : -__builtin_inff())
#define MASKT(P0_, P1_, t) do { const int kb_ = KBASE(t); if (kb_ + KVBLK - 1 > qlo) mask_tile(P0_, P1_, qm - kb_); } while (0)
    f32x16 pA0, pA1, pB0, pB1; float mnA, mnB, alA, alB; bf16x8 pa0, pa1, pa2, pa3;
    SWRITE_HV(0); SBAR();
    if (NT > 1) SLOAD_H(KBASE(1));
    SBAR(); qkt<0>(pA0, pA1, K_lds, r32, hi, qr, BASE(0), beta);
    MASKT(pA0, pA1, 0); partialSM(pA0, pA1, m_reg, mnA, alA);
    if (NT > 1) { VMW(); SWRITE_H(1); }
    __syncthreads();
#define HALF_STEP(PX0, PX1, mnX, alX, PY0, PY1, alY, t, KB, VB, SB) do {                                                      \
        SBAR(); qkt<KB>(PX0, PX1, K_lds, r32, hi, qr, BASE(t), beta);                                                         \
        finishSM(PY0, PY1, alY, l_reg, pa0, pa1, pa2, pa3); SBAR();                                                           \
        if ((t) + 1 < NT) { SLOAD_H(KBASE((t) + 1)); SBAR(); }                                                                \
        pv_tile<VB>(o, vb0, pa0, pa1, pa2, pa3); MASKT(PX0, PX1, (t)); partialSM(PX0, PX1, m_reg, mnX, alX);                  \
        __syncthreads();                                                                                                      \
        if ((t) + 1 < NT) { VMW(); SWRITE_H(SB); }                                                                            \
        RESC(alX); __syncthreads(); } while (0)
    for (int t = 1; t + 1 < NT; t += 2) {
        HALF_STEP(pB0, pB1, mnB, alB, pA0, pA1, alA, t, 1, 0, 0);
        HALF_STEP(pA0, pA1, mnA, alA, pB0, pB1, alB, t + 1, 0, 1, 1);
    }
    SBAR(); qkt<1>(pB0, pB1, K_lds, r32, hi, qr, BASE(NT - 1), beta); SBAR();
    finishSM(pA0, pA1, alA, l_reg, pa0, pa1, pa2, pa3); SBAR();
    pv_tile<0>(o, vb0, pa0, pa1, pa2, pa3);
    MASKT(pB0, pB1, NT - 1); partialSM(pB0, pB1, m_reg, mnB, alB); __syncthreads(); RESC(alB);
    finishSM(pB0, pB1, alB, l_reg, pa0, pa1, pa2, pa3); SBAR(); pv_tile<1>(o, vb0, pa0, pa1, pa2, pa3);
    { int t2 = threadIdx.x; asm volatile("" : "+v"(t2)); const int r32e = t2 & 31, hie = (t2 >> 5) & 1;
      float* wse = (float*)(lds + LDS_WS) + wid * 64;
      if (hie == 0) wse[r32e] = l_reg; asm volatile("s_waitcnt lgkmcnt(0)" ::: "memory");
      bf16* Ow = O + (size_t)(P0 + wid * QBLK) * OP + r32e;
#pragma unroll
      for (int r = 0; r < 16; ++r) { const int orow = crow(r, hie); const float rl = __builtin_amdgcn_rcpf(wse[orow]);
#pragma unroll
        for (int d0 = 0; d0 < 4; ++d0) { const float v = o[d0][r] * rl; const float vn = __shfl_xor(v, 1);
            if ((r32e & 1) == 0) *(unsigned*)(Ow + (size_t)orow * OP + d0 * 32) = cvtpk(v, vn); } } }
#undef RESC
#undef KBASE
#undef BASE
#undef MASKT
#undef HALF_STEP
#undef ROW
#undef VMW
#undef SLOAD_H
#undef SWRITE_HK
#undef SWRITE_HV
#undef SWRITE_H
}
#undef KSWZ
#undef SBAR
}

namespace hg {
typedef short bf16x8 __attribute__((ext_vector_type(8)));
typedef float f32x4 __attribute__((ext_vector_type(4)));
typedef float f32x2 __attribute__((ext_vector_type(2)));
typedef unsigned u32x4 __attribute__((ext_vector_type(4)));
typedef unsigned u32x2 __attribute__((ext_vector_type(2)));
typedef unsigned short bf16;
#define HLAS __attribute__((address_space(3)))
constexpr int RS = 272, RS64 = 144;
constexpr int O_QT = 0, O_KT = O_QT + 64 * RS, O_KHT = O_KT + 64 * RS, O_IT = O_KHT + 128 * RS64, O_ST = O_IT + 128 * RS64, O_A = O_ST + 128 * RS, O_SEG = O_A + 64 * RS64,
              O_EM = O_SEG + 4096, O_DL = O_EM + 512, O_SSQ = O_DL + 512, O_END = O_SSQ + 2048;
static_assert(O_END <= 131072, "hgrn LDS map");
constexpr int PP = 7168, OP = 2048;
__device__ __forceinline__ float lo(unsigned w) { return __uint_as_float(w << 16); }
__device__ __forceinline__ float hi(unsigned w) { return __uint_as_float(w & 0xffff0000u); }
typedef __bf16 bf16x2_t __attribute__((ext_vector_type(2)));
__device__ __forceinline__ unsigned cvtpk(float a, float b) { const f32x2 v = {a, b}; const bf16x2_t h = __builtin_convertvector(v, bf16x2_t); return __builtin_bit_cast(unsigned, h); }
__device__ __forceinline__ float sigm(float x) { return __builtin_amdgcn_rcpf(1.f + __expf(-x)); }
constexpr int IMG_BYTES = 50176, IMG_KHT = 16384, IMG_IT = 32768, IMG_DL = 49152, OI_BYTES = 16384;
#define HP_LOAD(c_) do { const unsigned short* p_ = (const unsigned short*)Pq + (size_t)((c_) * 64 + 8 * w) * 7168 + 2 * lane; _Pragma("unroll") for (int tt = 0; tt < 8; ++tt) { \
        qw[tt] = *(const unsigned*)(p_ + (size_t)tt * 7168); fw[tt] = *(const unsigned*)(p_ + (size_t)tt * 7168 + 1024); iw[tt] = *(const unsigned*)(p_ + (size_t)tt * 7168 + 2048); } } while (0)
__device__ __forceinline__ void hgrn_produce(const bf16* Pq, const float* lbl, unsigned char* img, unsigned char* oi, HLAS unsigned char* L, int c, int cnext, unsigned (&qw)[8], unsigned (&fw)[8], unsigned (&iw)[8]) {
    int tid = threadIdx.x; asm volatile("" : "+v"(tid));
    const int w = __builtin_amdgcn_readfirstlane(tid >> 6), lane = tid & 63, fr = lane & 15, fq = lane >> 4;
    const float lb0 = sigm(lbl[2 * lane] - lbl[1024 + 2 * lane]), lb1 = sigm(lbl[2 * lane + 1] - lbl[1024 + 2 * lane + 1]);
    float cs0[8], cs1[8], kf0[8], kf1[8]; float run0 = 0.f, run1 = 0.f;
#pragma unroll
    for (int tt = 0; tt < 8; ++tt) { const float f0 = lb0 + (1.f - lb0) * sigm(lo(fw[tt])), f1 = lb1 + (1.f - lb1) * sigm(hi(fw[tt]));
        run0 += __logf(f0); run1 += __logf(f1); cs0[tt] = run0; cs1[tt] = run1; kf0[tt] = 1.f - f0; kf1[tt] = 1.f - f1; }
    __syncthreads();
    *(HLAS f32x2*)(L + O_SEG + (w * 128 + 2 * lane) * 4) = (f32x2){run0, run1};
    __syncthreads();
    float pre0 = 0.f, pre1 = 0.f, bm0 = 0.f, bm1 = 0.f, bl0 = 0.f, bl1 = 0.f;
#pragma unroll
    for (int ww = 0; ww < 8; ++ww) { const f32x2 sg = *(const HLAS f32x2*)(L + O_SEG + (ww * 128 + 2 * lane) * 4);
        if (ww < w) { pre0 += sg.x; pre1 += sg.y; } if (ww < 4) { bm0 += sg.x; bm1 += sg.y; } bl0 += sg.x; bl1 += sg.y; }
    unsigned kh0[4], kh1[4], it0[4], it1[4];
#pragma unroll
    for (int tt = 0; tt < 8; tt += 2) {
        float h0[2], h1[2];
#pragma unroll
        for (int u = 0; u < 2; ++u) { const int t2 = tt + u; const int t = 8 * w + t2; const float b0 = pre0 + cs0[t2], b1 = pre1 + cs1[t2];
            const float e10 = __expf(b0 - bm0), e11 = __expf(b1 - bm1), e20 = __expf(bm0 - b0), e21 = __expf(bm1 - b1), e30 = __expf(bl0 - b0), e31 = __expf(bl1 - b1);
            const float q0 = lo(qw[t2]), q1 = hi(qw[t2]); const float s0 = q0 * sigm(q0), s1 = q1 * sigm(q1);
            *(HLAS unsigned*)(L + O_QT + t * RS + 4 * lane) = cvtpk(s0 * e10, s1 * e11);
            *(HLAS unsigned*)(L + O_KT + t * RS + 4 * lane) = cvtpk(kf0[t2] * e20, kf1[t2] * e21);
            *(unsigned*)(img + t * 256 + ((((lane >> 2) ^ (t & 15)) << 4) | ((4 * lane) & 15))) = cvtpk(s0 * __expf(b0), s1 * __expf(b1));
            h0[u] = kf0[t2] * e30; h1[u] = kf1[t2] * e31; }
        kh0[tt >> 1] = cvtpk(h0[0], h0[1]); kh1[tt >> 1] = cvtpk(h1[0], h1[1]);
        it0[tt >> 1] = (iw[tt] & 0xffffu) | (iw[tt + 1] << 16); it1[tt >> 1] = (iw[tt] >> 16) | (iw[tt + 1] & 0xffff0000u); }
    *(HLAS u32x4*)(L + O_IT + (2 * lane) * RS64 + 16 * w) = (u32x4){it0[0], it0[1], it0[2], it0[3]};
    *(HLAS u32x4*)(L + O_IT + (2 * lane + 1) * RS64 + 16 * w) = (u32x4){it1[0], it1[1], it1[2], it1[3]};
    { const int sw = (w ^ (lane & 7)) << 4;
      *(u32x4*)(img + IMG_KHT + (2 * lane) * 128 + sw) = (u32x4){kh0[0], kh0[1], kh0[2], kh0[3]};
      *(u32x4*)(img + IMG_KHT + (2 * lane + 1) * 128 + sw) = (u32x4){kh1[0], kh1[1], kh1[2], kh1[3]};
      *(u32x4*)(img + IMG_IT + (2 * lane) * 128 + sw) = (u32x4){it0[0], it0[1], it0[2], it0[3]};
      *(u32x4*)(img + IMG_IT + (2 * lane + 1) * 128 + sw) = (u32x4){it1[0], it1[1], it1[2], it1[3]}; }
    if (w == 0) *(f32x2*)(img + IMG_DL + 8 * lane) = (f32x2){__expf(bl0), __expf(bl1)};
    if (cnext >= 0) HP_LOAD(cnext);
    __syncthreads();
    { const int tt = w >> 1;
#pragma unroll
      for (int si = 0; si < 2; ++si) { const int ss = 2 * (w & 1) + si; u32x2 outw = (u32x2){0u, 0u};
        if (ss <= tt) { f32x4 acc = (f32x4){0.f, 0.f, 0.f, 0.f};
#pragma unroll
            for (int kk = 0; kk < 4; ++kk) { const bf16x8 a = *(const HLAS bf16x8*)(L + O_KT + (16 * ss + fr) * RS + (32 * kk + 8 * fq) * 2), b = *(const HLAS bf16x8*)(L + O_QT + (16 * tt + fr) * RS + (32 * kk + 8 * fq) * 2);
                acc = __builtin_amdgcn_mfma_f32_16x16x32_bf16(a, b, acc, 0, 0, 0); }
#pragma unroll
            for (int r = 0; r < 4; ++r) if (16 * ss + 4 * fq + r > 16 * tt + fr) acc[r] = 0.f;
            outw = (u32x2){cvtpk(acc[0], acc[1]), cvtpk(acc[2], acc[3])}; }
        *(HLAS u32x2*)(L + O_A + (16 * tt + fr) * RS64 + (16 * ss + 4 * fq) * 2) = outw; } }
    __syncthreads();
    bf16x8 itf[2];
#pragma unroll
    for (int kk = 0; kk < 2; ++kk) itf[kk] = *(const HLAS bf16x8*)(L + O_IT + (16 * w + fr) * RS64 + (32 * kk + 8 * fq) * 2);
#pragma unroll
    for (int tt = 0; tt < 4; ++tt) { f32x4 acc = (f32x4){0.f, 0.f, 0.f, 0.f};
#pragma unroll
        for (int kk = 0; kk < 2; ++kk) { const bf16x8 b = *(const HLAS bf16x8*)(L + O_A + (16 * tt + fr) * RS64 + (32 * kk + 8 * fq) * 2); acc = __builtin_amdgcn_mfma_f32_16x16x32_bf16(itf[kk], b, acc, 0, 0, 0); }
        *(u32x2*)(oi + ((tt * 8 + w) * 64 + lane) * 8) = (u32x2){cvtpk(acc[0], acc[1]), cvtpk(acc[2], acc[3])}; }
}
constexpr int ST_BYTES = 32768;
__device__ __forceinline__ void hgrn_scan(const unsigned char* img0, unsigned char* st0, HLAS unsigned char* L, int nchunk) {
    int tid = threadIdx.x; asm volatile("" : "+v"(tid));
    const int w = __builtin_amdgcn_readfirstlane(tid >> 6), lane = tid & 63, fr = lane & 15, fq = lane >> 4;
    f32x4 Sacc[8];
#pragma unroll
    for (int kt = 0; kt < 8; ++kt) Sacc[kt] = (f32x4){0.f, 0.f, 0.f, 0.f};
#define HS_DMA(c, buf) do { const unsigned char* g_ = img0 + (size_t)(c) * IMG_BYTES + lane * 16; _Pragma("unroll") for (int p_ = 2; p_ < 6; ++p_) \
        __builtin_amdgcn_global_load_lds((const unsigned*)(g_ + (p_ * 8 + w) * 1024), (HLAS unsigned*)(L + (buf) * IMG_BYTES + (p_ * 8 + w) * 1024), 16, 0, 0); \
        if (w == 0) __builtin_amdgcn_global_load_lds((const unsigned*)(g_ + 48 * 1024), (HLAS unsigned*)(L + (buf) * IMG_BYTES + 48 * 1024), 16, 0, 0); } while (0)
    __syncthreads();
    HS_DMA(0, 0);
    asm volatile("s_waitcnt vmcnt(0)" ::: "memory"); __syncthreads();
    for (int c = 0; c < nchunk; ++c) {
        HLAS unsigned char* B = L + (c & 1) * IMG_BYTES;
        if (c + 1 < nchunk) HS_DMA(c + 1, (c + 1) & 1);
        unsigned char* stc = st0 + (size_t)c * ST_BYTES + (16 * w + fr) * 256 + 8 * (fq & 1);
#pragma unroll
        for (int kt = 0; kt < 8; ++kt) *(u32x2*)(stc + (((2 * kt + (fq >> 1)) ^ fr) << 4)) = (u32x2){cvtpk(Sacc[kt][0], Sacc[kt][1]), cvtpk(Sacc[kt][2], Sacc[kt][3])};
        bf16x8 itf[2], kf[8][2]; f32x4 dv[8];
#pragma unroll
        for (int kk = 0; kk < 2; ++kk) itf[kk] = *(const HLAS bf16x8*)(B + IMG_IT + (16 * w + fr) * 128 + (((4 * kk + fq) ^ (fr >> 1)) << 4));
#pragma unroll
        for (int kt = 0; kt < 8; ++kt) { dv[kt] = *(const HLAS f32x4*)(B + IMG_DL + (16 * kt + 4 * fq) * 4);
#pragma unroll
            for (int kk = 0; kk < 2; ++kk) kf[kt][kk] = *(const HLAS bf16x8*)(B + IMG_KHT + (16 * kt + fr) * 128 + (((4 * kk + fq) ^ (fr >> 1)) << 4)); }
#pragma unroll
        for (int kt = 0; kt < 8; ++kt) { f32x4 acc = Sacc[kt] * dv[kt];
#pragma unroll
            for (int kk = 0; kk < 2; ++kk) acc = __builtin_amdgcn_mfma_f32_16x16x32_bf16(kf[kt][kk], itf[kk], acc, 0, 0, 0);
            Sacc[kt] = acc; }
        asm volatile("s_waitcnt vmcnt(0) lgkmcnt(0)" ::: "memory"); __builtin_amdgcn_s_barrier(); asm volatile("" ::: "memory");
    }
#undef HS_DMA
}
constexpr int F_QT = 0, F_ST = 16384, F_SSQ = 49152, F_END = F_SSQ + 2048;
__device__ __forceinline__ void hgrn_finish(const unsigned char* img, const unsigned char* st, const unsigned char* oi, const bf16* Pg  , bf16* Oc  , const float* gnorm, HLAS unsigned char* L) {
    int tid = threadIdx.x; asm volatile("" : "+v"(tid));
    const int w = __builtin_amdgcn_readfirstlane(tid >> 6), lane = tid & 63, fr = lane & 15, fq = lane >> 4;
    const f32x4 gn = *(const f32x4*)(gnorm + 16 * w + 4 * fq);
    __syncthreads();
#pragma unroll
    for (int p_ = 0; p_ < 2; ++p_) __builtin_amdgcn_global_load_lds((const unsigned*)(img + lane * 16 + (p_ * 8 + w) * 1024), (HLAS unsigned*)(L + F_QT + (p_ * 8 + w) * 1024), 16, 0, 0);
#pragma unroll
    for (int p_ = 0; p_ < 4; ++p_) __builtin_amdgcn_global_load_lds((const unsigned*)(st + lane * 16 + (p_ * 8 + w) * 1024), (HLAS unsigned*)(L + F_ST + (p_ * 8 + w) * 1024), 16, 0, 0);
    u32x2 gw[4], ow[4];
#pragma unroll
    for (int tt = 0; tt < 4; ++tt) { gw[tt] = *(const u32x2*)(Pg + (size_t)(16 * tt + fr) * PP + 16 * w + 4 * fq); ow[tt] = *(const u32x2*)(oi + ((tt * 8 + w) * 64 + lane) * 8); }
    asm volatile("s_waitcnt vmcnt(0)" ::: "memory"); __syncthreads();
    bf16x8 stf[4], qf[4][4];
#pragma unroll
    for (int kk = 0; kk < 4; ++kk) stf[kk] = *(const HLAS bf16x8*)(L + F_ST + (16 * w + fr) * 256 + (((4 * kk + fq) ^ fr) << 4));
#pragma unroll
    for (int tt = 0; tt < 4; ++tt)
#pragma unroll
        for (int kk = 0; kk < 4; ++kk) qf[tt][kk] = *(const HLAS bf16x8*)(L + F_QT + (16 * tt + fr) * 256 + (((4 * kk + fq) ^ fr) << 4));
    f32x4 oacc[4];
#pragma unroll
    for (int tt = 0; tt < 4; ++tt) { f32x4 acc = (f32x4){lo(ow[tt].x), hi(ow[tt].x), lo(ow[tt].y), hi(ow[tt].y)};
#pragma unroll
        for (int kk = 0; kk < 4; ++kk) acc = __builtin_amdgcn_mfma_f32_16x16x32_bf16(stf[kk], qf[tt][kk], acc, 0, 0, 0);
        oacc[tt] = acc; float ss = (acc[0] * acc[0] + acc[1] * acc[1]) + (acc[2] * acc[2] + acc[3] * acc[3]);
        ss += __shfl_xor(ss, 16); ss += __shfl_xor(ss, 32);
        if (fq == 0) *(HLAS float*)(L + F_SSQ + ((16 * tt + fr) * 8 + w) * 4) = ss; }
    __syncthreads();
#pragma unroll
    for (int tt = 0; tt < 4; ++tt) { const f32x4 s0 = *(const HLAS f32x4*)(L + F_SSQ + (16 * tt + fr) * 32), s1 = *(const HLAS f32x4*)(L + F_SSQ + (16 * tt + fr) * 32 + 16);
        const float tot = ((s0[0] + s0[1]) + (s0[2] + s0[3])) + ((s1[0] + s1[1]) + (s1[2] + s1[3]));
        const float rstd = 1.0f / sqrtf(tot * (1.f / 128.f) + 1e-6f);
        const float g0 = lo(gw[tt].x), g1 = hi(gw[tt].x), g2 = lo(gw[tt].y), g3 = hi(gw[tt].y);
        const float y0 = oacc[tt][0] * rstd * gn[0] * (g0 * sigm(g0)), y1 = oacc[tt][1] * rstd * gn[1] * (g1 * sigm(g1)), y2 = oacc[tt][2] * rstd * gn[2] * (g2 * sigm(g2)), y3 = oacc[tt][3] * rstd * gn[3] * (g3 * sigm(g3));
        *(u32x2*)(Oc + (size_t)(16 * tt + fr) * OP + 16 * w + 4 * fq) = (u32x2){cvtpk(y0, y1), cvtpk(y2, y3)}; }
}
#undef HLAS
}

constexpr int NWAVES = 8;
constexpr int N_LAUNCHES = MK_N_LAUNCHES;
constexpr int PER_PHASE = 9;
constexpr int DM = 2048, NB = 4, SEQ = 2048, M = NB * SEQ, INC = 7168, AW = 1024, HD = 128, NH = 8, NE = 16, DE = 1024;
constexpr int MOBA_BS = 256, MOBA_NB = SEQ / MOBA_BS;
constexpr float RMS_EPS = 1e-6f;
constexpr int SLOT_CAP = 2 * M + NE * 256;

constexpr size_t MiB = 1u << 20;
constexpr size_t WS_CTL = 0, CTL_ZERO_BYTES = 128 * 1024;
constexpr size_t WS_WIN = 2 * MiB;
constexpr size_t WS_WOUT = 30 * MiB;
constexpr size_t WS_WGU = 38 * MiB;
constexpr size_t WS_WD = 166 * MiB;
constexpr size_t WS_XN = 230 * MiB;
constexpr size_t WS_PROJ = 262 * MiB;
constexpr size_t WS_CAT = 374 * MiB;
constexpr size_t WS_X1 = 406 * MiB;
constexpr size_t WS_MISC = 470 * MiB;
constexpr size_t WS_END = 472 * MiB;
constexpr size_t WS_HIMG = WS_X1;
constexpr size_t WS_HST = 472 * MiB;
constexpr size_t WS_HOI = WS_XN;
constexpr size_t WS_HID = 342 * MiB;
constexpr size_t WS_Y = 262 * MiB;
static_assert(WS_HID + (size_t)SLOT_CAP * DE <= WS_X1 && WS_Y + (size_t)2 * M * DM * 2 <= WS_HID, "overlay map");
constexpr size_t MS_WRT = 0;
constexpr size_t MS_ROWL = 512 * 1024;
constexpr size_t MS_WL = 1024 * 1024;
constexpr int CW_TMO = 0, CW_CODE = 1;
constexpr int CW_BAR = 4096;
constexpr int CW_HFLAG = 20480;
constexpr int CW_CNT = 16384;

constexpr int RING_OFF = 0, RING_BYTES = 147456;
constexpr int LDSCTL_OFF = RING_BYTES, MISC_OFF = LDSCTL_OFF + 320;
constexpr int LDS_BYTES = 149504;

#define GAS __attribute__((address_space(1)))
#define LAS __attribute__((address_space(3)))
typedef unsigned short bf16;
typedef unsigned v4u __attribute__((ext_vector_type(4)));
typedef unsigned v2u __attribute__((ext_vector_type(2)));
typedef float f32x4 __attribute__((ext_vector_type(4)));
typedef float f32x2 __attribute__((ext_vector_type(2)));
typedef int i32x4 __attribute__((ext_vector_type(4)));
typedef GAS unsigned gu32;
#define RLX_AGENT __ATOMIC_RELAXED, __HIP_MEMORY_SCOPE_AGENT
#define LDS_WAIT() asm volatile("s_waitcnt lgkmcnt(0)" ::: "memory")
#define VM_WAIT() asm volatile("s_waitcnt vmcnt(0)" ::: "memory")
__device__ __forceinline__ unsigned f2bf(float f) { unsigned u = __builtin_bit_cast(unsigned, f); return (u + 0x7fffu + ((u >> 16) & 1u)) >> 16; }
__device__ __forceinline__ unsigned pk2(float lo, float hi) { return f2bf(lo) | (f2bf(hi) << 16); }
__device__ __forceinline__ float bf_lo(unsigned w) { return __uint_as_float(w << 16); }
__device__ __forceinline__ float bf_hi(unsigned w) { return __uint_as_float(w & 0xffff0000u); }
__device__ __forceinline__ float bf1(bf16 h) { return __uint_as_float((unsigned)h << 16); }

#define XB_TMO      128
#define XB_XCNT(j)  (256  + 64 * (j))
#define XB_XSUB(j)  (1280 + 64 * (j))
#define XB_XGEN(j)  (2304 + 64 * (j))
#define XB_TOP      3328
#define XB_TOPGEN   3392
#define XCD_BAR_WORDS 3456
#define XB_SPIN_CAP (1u << 18)
__device__ __forceinline__ unsigned xb_ld(unsigned* p)              { return __hip_atomic_load(p, __ATOMIC_RELAXED, __HIP_MEMORY_SCOPE_AGENT); }
__device__ __forceinline__ unsigned xb_add(unsigned* p, unsigned v) { return __hip_atomic_fetch_add(p, v, __ATOMIC_RELAXED, __HIP_MEMORY_SCOPE_AGENT); }
__device__ __forceinline__ unsigned xb_xcc_id() { return (unsigned)__builtin_amdgcn_s_getreg((3 << 11) | 20) & 0xFu; }
#define XB_SPIN(cond, bar) do { unsigned _sp = 0; while (cond) { __builtin_amdgcn_s_sleep(1); \
    if ((++_sp & 255u) == 0u) { if (xb_ld(&(bar)[XB_TMO])) break; if (_sp > XB_SPIN_CAP) { atomicAdd(&(bar)[XB_TMO], 1u); break; } } } } while (0)
struct XcdBarrier { unsigned* bar; unsigned x; volatile LAS unsigned* st; };
__device__ __forceinline__ XcdBarrier xcd_barrier_post(unsigned* bar, volatile LAS unsigned* st) {
    XcdBarrier b; b.bar = bar; b.x = xb_xcc_id(); b.st = st;
    if (threadIdx.x == 0) (void)xb_add(&bar[XB_XCNT(b.x)], 1u);
    return b;
}
__device__ __forceinline__ void xcd_barrier_complete(unsigned* bar, unsigned x, unsigned& nloc, unsigned& nx) {
    const unsigned G = gridDim.x * gridDim.y * gridDim.z;
    unsigned sum, cnt, mine, sp = 0u;
    for (;;) {
        sum = 0u; cnt = 0u; mine = 0u;
#pragma unroll
        for (unsigned j = 0; j < 16; ++j) { const unsigned c = xb_ld(&bar[XB_XCNT(j)]); sum += c; cnt += (c > 0u) ? 1u : 0u; mine = (j == x) ? c : mine; }
        if (sum == G) break;
        __builtin_amdgcn_s_sleep(1);
        if ((++sp & 255u) == 0u) { if (xb_ld(&bar[XB_TMO])) break; if (sp > XB_SPIN_CAP) { atomicAdd(&bar[XB_TMO], 1u); break; } }
    }
    nloc = mine > 0u ? mine : 1u; nx = cnt > 0u ? cnt : 1u;
}
__device__ __forceinline__ void xcd_barrier(const XcdBarrier& b) {
    asm volatile("s_waitcnt vmcnt(0)" ::: "memory");
    __syncthreads();
    if (threadIdx.x == 0) {
        unsigned* bar = b.bar;
        __builtin_amdgcn_s_waitcnt(0);
        unsigned nloc = b.st[0], nx = b.st[1];
        if (nloc == 0u) { xcd_barrier_complete(bar, b.x, nloc, nx); b.st[0] = nloc; b.st[1] = nx; }
        const unsigned old = xb_add(&bar[XB_XSUB(b.x)], 1u);
        const unsigned gen = old / nloc;
        if (old + 1u == (gen + 1u) * nloc) {
            __builtin_amdgcn_fence(__ATOMIC_RELEASE, "agent");
            asm volatile("s_waitcnt vmcnt(0)" ::: "memory");
            const unsigned og = xb_add(&bar[XB_TOP], 1u);
            const unsigned tg = og / nx;
            if (og + 1u == (tg + 1u) * nx) xb_add(&bar[XB_TOPGEN], 1u);
            else XB_SPIN(xb_ld(&bar[XB_TOPGEN]) == tg, bar);
            __builtin_amdgcn_fence(__ATOMIC_ACQUIRE, "agent");
            xb_add(&bar[XB_XGEN(b.x)], 1u);
            asm volatile("s_waitcnt vmcnt(0)" ::: "memory");
        } else {
            XB_SPIN(xb_ld(&bar[XB_XGEN(b.x)]) == gen, bar);
            __builtin_amdgcn_fence(__ATOMIC_ACQUIRE, "agent");
            asm volatile("s_waitcnt vmcnt(0)" ::: "memory");
        }
    }
    __syncthreads();
}

struct Args { const float* in[15]; float* out; unsigned char* ws; int ph_lo, ph_hi, li, pad; };

struct Frame {
    LAS unsigned char* lds;
    volatile LAS unsigned* MISC;
    gu32* ctl;
    int tid, lane, wave;
    int vcu, G;
    const float* x; float* out;
    const float *g_mix, *w_in, *lb_logits, *g_onorm, *w_out, *g_ffn, *w_grp, *b_grp, *w_er, *b_er, *w_gate, *w_up, *w_down, *g_fin;
    bf16 *WIN, *WOUT, *WGU, *WD, *XN, *PROJ, *CAT, *HID, *Y;
    float* X1; float* WRT; int* ROWL; float* WL;
};
__device__ __forceinline__ void set_ptrs(Frame& F) {
    const __attribute__((address_space(4))) Args* ap = (const __attribute__((address_space(4))) Args*)__builtin_amdgcn_kernarg_segment_ptr();
    asm volatile("" : "+s"(ap));
    unsigned char* ws = ap->ws;
    F.ctl = (gu32*)(ws + WS_CTL);
    F.x = ap->in[0]; F.g_mix = ap->in[1]; F.w_in = ap->in[2]; F.lb_logits = ap->in[3]; F.g_onorm = ap->in[4]; F.w_out = ap->in[5]; F.g_ffn = ap->in[6];
    F.w_grp = ap->in[7]; F.b_grp = ap->in[8]; F.w_er = ap->in[9]; F.b_er = ap->in[10]; F.w_gate = ap->in[11]; F.w_up = ap->in[12]; F.w_down = ap->in[13]; F.g_fin = ap->in[14];
    F.out = ap->out;
    F.WIN = (bf16*)(ws + WS_WIN); F.WOUT = (bf16*)(ws + WS_WOUT); F.WGU = (bf16*)(ws + WS_WGU); F.WD = (bf16*)(ws + WS_WD);
    F.XN = (bf16*)(ws + WS_XN); F.PROJ = (bf16*)(ws + WS_PROJ); F.CAT = (bf16*)(ws + WS_CAT); F.X1 = (float*)(ws + WS_X1);
    F.HID = (bf16*)(ws + WS_HID); F.Y = (bf16*)(ws + WS_Y);
    F.WRT = (float*)(ws + WS_MISC + MS_WRT); F.ROWL = (int*)(ws + WS_MISC + MS_ROWL); F.WL = (float*)(ws + WS_MISC + MS_WL);
}
__device__ __forceinline__ float wave_sum(float v) {
#pragma unroll
    for (int o = 1; o < 64; o <<= 1) v += __shfl_xor(v, o);
    return v;
}
template <bool FP8>
__device__ __forceinline__ void xpose_item(const float* W, int N, void* WT, int Kd, int k0, int n0, int drow0, LAS float* scr, int lane, float mul) {
    { const int kq = lane >> 4, c4 = lane & 15;
#pragma unroll
      for (int i = 0; i < 16; ++i) { const int kk = 4 * i + kq; const f32x4 v = *(const GAS f32x4*)(W + (size_t)(k0 + kk) * N + n0 + 4 * c4);
          *(LAS f32x4*)(scr + kk * 64 + 4 * (c4 ^ ((kk >> 3) & 7))) = v; } }
    LDS_WAIT(); asm volatile("" ::: "memory");
    if constexpr (!FP8) { const int c = lane & 7;
#pragma unroll
        for (int j = 0; j < 8; ++j) { const int n = (lane >> 3) + 8 * j; const LAS float* sp = scr + (8 * c) * 64 + (n ^ (c << 2));
            v4u o; o.x = pk2(sp[0 * 64], sp[1 * 64]); o.y = pk2(sp[2 * 64], sp[3 * 64]); o.z = pk2(sp[4 * 64], sp[5 * 64]); o.w = pk2(sp[6 * 64], sp[7 * 64]);
            *(GAS v4u*)((bf16*)WT + (size_t)(drow0 + n) * Kd + k0 + 8 * c) = o; } }
    else { const int c = lane & 3;
#pragma unroll
        for (int j = 0; j < 4; ++j) { const int n = (lane >> 2) + 16 * j; const LAS float* s0 = scr + (16 * c) * 64 + (n ^ ((2 * c) << 2)); const LAS float* s1 = scr + (16 * c + 8) * 64 + (n ^ ((2 * c + 1) << 2));
            v4u o;
            o.x = pg8::pk4_fp8(s0[0 * 64] * mul, s0[1 * 64] * mul, s0[2 * 64] * mul, s0[3 * 64] * mul); o.y = pg8::pk4_fp8(s0[4 * 64] * mul, s0[5 * 64] * mul, s0[6 * 64] * mul, s0[7 * 64] * mul);
            o.z = pg8::pk4_fp8(s1[0 * 64] * mul, s1[1 * 64] * mul, s1[2 * 64] * mul, s1[3 * 64] * mul); o.w = pg8::pk4_fp8(s1[4 * 64] * mul, s1[5 * 64] * mul, s1[6 * 64] * mul, s1[7 * 64] * mul);
            *(GAS v4u*)((unsigned char*)WT + (size_t)(drow0 + n) * Kd + k0 + 16 * c) = o; } }
    LDS_WAIT(); asm volatile("" ::: "memory");
}
__device__ __forceinline__ void rms_row_to_bf16(int lane, const float* xrow, const float* g, bf16* orow) {
    const GAS f32x4* xr = (const GAS f32x4*)xrow + lane; const GAS f32x4* gr = (const GAS f32x4*)g + lane;
    f32x4 v[8]; float s = 0.f;
#pragma unroll
    for (int j = 0; j < 8; ++j) { v[j] = xr[64 * j]; s += (v[j].x * v[j].x + v[j].y * v[j].y) + (v[j].z * v[j].z + v[j].w * v[j].w); }
    const float rstd = 1.0f / sqrtf(wave_sum(s) * (1.f / DM) + RMS_EPS);
    GAS v2u* o8 = (GAS v2u*)orow + lane;
#pragma unroll
    for (int j = 0; j < 8; ++j) { const f32x4 gg = gr[64 * j]; v2u o; o.x = pk2(v[j].x * rstd * gg.x, v[j].y * rstd * gg.y); o.y = pk2(v[j].z * rstd * gg.z, v[j].w * rstd * gg.w); o8[64 * j] = o; }
}

constexpr int I_IN = (DM / 64) * (INC / 64), I_OUT = (DM / 64) * (DM / 64), I_G = NE * (DM / 64) * (DE / 64), I_D = NE * (DE / 64) * (DM / 64);
constexpr int I_MOE = 2 * I_G + I_D;
constexpr int HID_P1 = 8, N_HID_P1 = 128 * 8 * HID_P1;
#ifndef P3_CVT_LIST
#define P3_CVT_LIST 0, 0, 0, 1, 0, 6, 11, 3
#endif
#ifndef P3_FIN_LIST
#define P3_FIN_LIST 5, 0, 2, 4, 6, 5, 5, 5
#endif
constexpr unsigned long long pack8(int a0, int a1, int a2, int a3, int a4, int a5, int a6, int a7, bool prefix) {
    const int a[8] = {a0, a1, a2, a3, a4, a5, a6, a7}; unsigned long long r = 0; int acc = 0;
    for (int i = 0; i < 8; ++i) { r |= (unsigned long long)(prefix ? acc : a[i]) << (8 * i); acc += a[i]; }
    return r;
}
constexpr int sum8(int a0, int a1, int a2, int a3, int a4, int a5, int a6, int a7) { return a0 + a1 + a2 + a3 + a4 + a5 + a6 + a7; }
constexpr unsigned long long P3_CVT = pack8(P3_CVT_LIST, false), P3_CVT_PRE = pack8(P3_CVT_LIST, true), P3_FIN = pack8(P3_FIN_LIST, false), P3_FIN_PRE = pack8(P3_FIN_LIST, true);
static_assert(sum8(P3_FIN_LIST) == 32, "the classes' finisher chunks cover one (b,h)");
constexpr int N_HID_P3 = 256 * sum8(P3_CVT_LIST);
constexpr int N_HID = N_HID_P1 + N_HID_P3;
constexpr int N_HID_P7 = 8192;
static_assert(N_HID + N_HID_P7 <= I_MOE && N_HID_P7 <= I_D, "hidden conversion items");
__device__ __forceinline__ void moe_item(Frame& F, int r, LAS float* scr, int lane) {
    if (r < 2 * I_G) { const int up = r >= I_G; if (up) r -= I_G; constexpr int per = (DM / 64) * (DE / 64); const int e = r / per, q = r % per, nblk = DE / 64, kb = q / nblk, nb = q % nblk, n0 = 64 * nb;
        const int drow = (n0 >> 7) * 256 + (n0 & 127) + up * 128;
        xpose_item<true>((up ? F.w_up : F.w_gate) + (size_t)e * DM * DE, DE, (unsigned char*)F.WGU + (size_t)e * 2048 * DM, DM, 64 * kb, n0, drow, scr, lane, 64.f); return; }
    r -= 2 * I_G;
    { constexpr int per = (DE / 64) * (DM / 64); const int e = r / per, q = r % per, nblk = DM / 64, kb = q / nblk, nb = q % nblk;
        xpose_item<true>(F.w_down + (size_t)e * DE * DM, DM, (unsigned char*)F.WD + (size_t)e * DM * DE, DE, 64 * kb, 64 * nb, 64 * nb, scr, lane, 32.f); }
}
__device__ __forceinline__ void moe_items_wave(Frame& F, int first, int cnt) {
    LAS float* scr = (LAS float*)(F.lds + RING_OFF + F.wave * 16384);
    for (int i = 0; i < cnt; ++i) moe_item(F, first + i, scr, F.lane);
}
__device__ __forceinline__ void p0_prologue(Frame& F) {
    LAS float* scr = (LAS float*)(F.lds + RING_OFF + F.wave * 16384);
    const int gw = F.vcu * NWAVES + F.wave, NGW = F.G * NWAVES;
    const int moe0 = (F.G == 256) ? N_HID : 0;
    const int NITEMS = I_IN + I_OUT + (I_MOE - moe0 - ((F.G == 256) ? N_HID_P7 : 0));
    for (int it = gw; it < NITEMS; it += NGW) {
        int r = it;
        if (r < I_IN) { const int nblk = INC / 64, kb = r / nblk, nb = r % nblk; xpose_item<false>(F.w_in, INC, F.WIN, DM, 64 * kb, 64 * nb, 64 * nb, scr, F.lane, 1.f); continue; } r -= I_IN;
        if (r < I_OUT) { const int nblk = DM / 64, kb = r / nblk, nb = r % nblk; xpose_item<false>(F.w_out, DM, F.WOUT, DM, 64 * kb, 64 * nb, 64 * nb, scr, F.lane, 1.f); continue; } r -= I_OUT;
        moe_item(F, moe0 + r, scr, F.lane);
    }
    for (int m = gw; m < M; m += NGW) rms_row_to_bf16(F.lane, F.x + (size_t)m * DM, F.g_mix, F.XN + (size_t)m * DM);
    for (int i = gw * 64 + F.lane; i < 20 * DM; i += NGW * 64) { const int c = i / DM, d = i % DM;
        const float w = c < 4 ? F.w_grp[d * 4 + c] : F.w_er[(size_t)((c - 4) >> 2) * DM * 4 + d * 4 + ((c - 4) & 3)];
        F.WRT[i] = w * F.g_ffn[d]; }
}

__device__ __forceinline__ void attn_item_mfma(Frame& F, char* lds, int item) {
    const int qb = 7 - (item >> 5), h = item & 7, b = (item >> 3) & 3;
    const bf16* Pb = F.PROJ + (size_t)b * SEQ * INC + h * HD;
    const float beta = exp2f(-(float)(h + 1)) * 11.313708498984761f;
    moba::moba_unit_ring(Pb, Pb + AW, Pb + 2 * AW, F.CAT + (size_t)b * SEQ * DM + h * HD, qb, beta, lds);
}
template <bool DRY> __device__ __forceinline__ void p4_router(Frame& F) {
    constexpr int NR = 4;
    const int gw = F.vcu * NWAVES + F.wave, NGW = F.G * NWAVES;
    for (int mb = gw * NR; mb < M; mb += NGW * NR) {
        int lane = F.lane; asm volatile("" : "+v"(lane));
        f32x4 v[NR][8]; float rstd[NR];
#pragma unroll
        for (int r = 0; r < NR; ++r) { const GAS v4u* xr = (const GAS v4u*)((const bf16*)F.X1 + (size_t)(mb + r) * DM) + lane;
#pragma unroll
            for (int j = 0; j < 4; ++j) { const v4u w = xr[64 * j]; v[r][2 * j] = (f32x4){bf_lo(w.x), bf_hi(w.x), bf_lo(w.y), bf_hi(w.y)}; v[r][2 * j + 1] = (f32x4){bf_lo(w.z), bf_hi(w.z), bf_lo(w.w), bf_hi(w.w)}; } }
#pragma unroll
        for (int r = 0; r < NR; ++r) { float s = 0.f;
#pragma unroll
            for (int j = 0; j < 8; ++j) s += (v[r][j].x * v[r][j].x + v[r][j].y * v[r][j].y) + (v[r][j].z * v[r][j].z + v[r][j].w * v[r][j].w);
            rstd[r] = 1.0f / sqrtf(wave_sum(s) * (1.f / DM) + RMS_EPS); }
        { const GAS f32x4* gr = (const GAS f32x4*)F.g_ffn + 2 * lane;
#pragma unroll
          for (int j = 0; j < 4; ++j) { const f32x4 g0 = gr[128 * j], g1 = gr[128 * j + 1];
#pragma unroll
            for (int r = 0; r < NR; ++r) { GAS v2u* o8 = (GAS v2u*)((unsigned char*)F.XN + (size_t)(mb + r) * DM) + lane; const float rs = rstd[r];
                v2u o; o.x = pg8::pk4_fp8(v[r][2 * j].x * rs * g0.x, v[r][2 * j].y * rs * g0.y, v[r][2 * j].z * rs * g0.z, v[r][2 * j].w * rs * g0.w);
                o.y = pg8::pk4_fp8(v[r][2 * j + 1].x * rs * g1.x, v[r][2 * j + 1].y * rs * g1.y, v[r][2 * j + 1].z * rs * g1.z, v[r][2 * j + 1].w * rs * g1.w); o8[64 * j] = o; } } }
        float gl[NR][4];
#pragma unroll
        for (int c = 0; c < 4; ++c) { const GAS f32x4* wr_ = (const GAS f32x4*)(F.WRT + (size_t)c * DM) + 2 * lane; float a[NR];
#pragma unroll
            for (int r = 0; r < NR; ++r) a[r] = 0.f;
#pragma unroll
            for (int j = 0; j < 8; ++j) { const f32x4 w = wr_[128 * (j >> 1) + (j & 1)];
#pragma unroll
                for (int r = 0; r < NR; ++r) a[r] += (v[r][j].x * w.x + v[r][j].y * w.y) + (v[r][j].z * w.z + v[r][j].w * w.w); }
            const float bg = F.b_grp[c];
#pragma unroll
            for (int r = 0; r < NR; ++r) gl[r][c] = wave_sum(a[r]) * rstd[r] + bg; }
        asm volatile("" ::: "memory");
        int g[NR]; float grp_w[NR];
#pragma unroll
        for (int r = 0; r < NR; ++r) { int gi = 0; float gmax = -INFINITY;
#pragma unroll
            for (int c = 0; c < 4; ++c) { if (gl[r][c] > gmax) { gmax = gl[r][c]; gi = c; } }
            float gs = 0.f;
#pragma unroll
            for (int c = 0; c < 4; ++c) gs += __expf(gl[r][c] - gmax);
            grp_w[r] = 1.f / gs; g[r] = __builtin_amdgcn_readfirstlane(gi); }
        float el[NR][4];
#pragma unroll
        for (int r = 0; r < NR; ++r)
#pragma unroll
            for (int e = 0; e < 4; ++e) { const GAS f32x4* wr_ = (const GAS f32x4*)(F.WRT + (size_t)(4 + 4 * g[r] + e) * DM) + 2 * lane; float a = 0.f;
#pragma unroll
                for (int j = 0; j < 8; ++j) { const f32x4 w = wr_[128 * (j >> 1) + (j & 1)]; a += (v[r][j].x * w.x + v[r][j].y * w.y) + (v[r][j].z * w.z + v[r][j].w * w.w); }
                el[r][e] = wave_sum(a) * rstd[r] + F.b_er[g[r] * 4 + e]; }
        int e0[NR], e1[NR]; float w0[NR], w1[NR];
#pragma unroll
        for (int r = 0; r < NR; ++r) { int i0 = 0; float m0 = -INFINITY;
#pragma unroll
            for (int e = 0; e < 4; ++e) if (el[r][e] > m0) { m0 = el[r][e]; i0 = e; }
            int i1 = 0; float m1 = -INFINITY;
#pragma unroll
            for (int e = 0; e < 4; ++e) if (e != i0 && el[r][e] > m1) { m1 = el[r][e]; i1 = e; }
            const float p1 = __expf(m1 - m0); w0[r] = grp_w[r] / (1.f + p1); w1[r] = grp_w[r] * p1 / (1.f + p1); e0[r] = g[r] * 4 + i0; e1[r] = g[r] * 4 + i1; }
        if (DRY) {
#pragma unroll
            for (int r = 0; r < NR; ++r) asm volatile("" :: "v"(w0[r]), "v"(w1[r]), "v"(e0[r]), "v"(e1[r])); }
        else if (lane == 0) { int p0[NR], p1_[NR];
#pragma unroll
            for (int r = 0; r < NR; ++r) { p0[r] = (int)__hip_atomic_fetch_add((unsigned*)(F.ctl + CW_CNT + 64 * e0[r]), 1u, RLX_AGENT); p1_[r] = (int)__hip_atomic_fetch_add((unsigned*)(F.ctl + CW_CNT + 64 * e1[r]), 1u, RLX_AGENT); }
#pragma unroll
            for (int r = 0; r < NR; ++r) { const int m = mb + r; F.ROWL[e0[r] * 8192 + p0[r]] = m; F.ROWL[e1[r] * 8192 + p1_[r]] = m | (1 << 16); F.WL[e0[r] * 8192 + p0[r]] = w0[r]; F.WL[e1[r] * 8192 + p1_[r]] = w1[r]; } }
    }
}
__device__ __forceinline__ void load_prefix(Frame& F, LAS int* pre) {
    if (F.tid < NE) pre[32 + F.tid] = (int)__hip_atomic_load((unsigned*)(F.ctl + CW_CNT + 64 * F.tid), RLX_AGENT);
    __syncthreads();
    if (F.tid == 0) { int a = 0;
        for (int e = 0; e < NE; ++e) { pre[e] = a; a += (pre[32 + e] + 255) >> 8; }
        pre[NE] = a; }
    __syncthreads();
}
__device__ __forceinline__ void p7_final(Frame& F) {
    const int gw = F.vcu * NWAVES + F.wave, NGW = F.G * NWAVES, lane = F.lane;
    for (int m = gw; m < M; m += NGW) {
        const GAS v4u* xr = (const GAS v4u*)((const bf16*)F.X1 + (size_t)m * DM) + lane; const GAS f32x4* gr = (const GAS f32x4*)F.g_fin + 2 * lane;
        const GAS v4u* y0 = (const GAS v4u*)(F.Y + (size_t)m * DM) + lane; const GAS v4u* y1 = (const GAS v4u*)(F.Y + (size_t)(M + m) * DM) + lane;
        f32x4 v[8]; float s = 0.f;
#pragma unroll
        for (int j = 0; j < 4; ++j) { const v4u x = xr[64 * j], a = y0[64 * j], c = y1[64 * j];
            v[2 * j] = (f32x4){bf_lo(x.x) + bf_lo(a.x) + bf_lo(c.x), bf_hi(x.x) + bf_hi(a.x) + bf_hi(c.x), bf_lo(x.y) + bf_lo(a.y) + bf_lo(c.y), bf_hi(x.y) + bf_hi(a.y) + bf_hi(c.y)};
            v[2 * j + 1] = (f32x4){bf_lo(x.z) + bf_lo(a.z) + bf_lo(c.z), bf_hi(x.z) + bf_hi(a.z) + bf_hi(c.z), bf_lo(x.w) + bf_lo(a.w) + bf_lo(c.w), bf_hi(x.w) + bf_hi(a.w) + bf_hi(c.w)}; }
#pragma unroll
        for (int j = 0; j < 8; ++j) s += (v[j].x * v[j].x + v[j].y * v[j].y) + (v[j].z * v[j].z + v[j].w * v[j].w);
        const float rstd = 1.0f / sqrtf(wave_sum(s) * (1.f / DM) + RMS_EPS);
        GAS f32x4* o = (GAS f32x4*)(F.out + (size_t)m * DM) + 2 * lane;
#pragma unroll
        for (int j = 0; j < 8; ++j) { const f32x4 gg = gr[128 * (j >> 1) + (j & 1)]; o[128 * (j >> 1) + (j & 1)] = (f32x4){v[j].x * rstd * gg.x, v[j].y * rstd * gg.y, v[j].z * rstd * gg.z, v[j].w * rstd * gg.w}; }
    }
}

__global__ void __launch_bounds__(NWAVES * 64, 2) skel_fwd(Args args) {
    extern __shared__ __attribute__((aligned(16))) unsigned char lds[];
    Frame F;
    F.lds = (LAS unsigned char*)lds;
    F.MISC = (volatile LAS unsigned*)(F.lds + MISC_OFF);
    F.tid = threadIdx.x; F.lane = F.tid & 63; F.wave = __builtin_amdgcn_readfirstlane(F.tid >> 6);
    F.G = gridDim.x; { const int bx = blockIdx.x; F.vcu = (F.G % 8 == 0) ? (bx % 8) * (F.G / 8) + bx / 8 : bx; }
    F.ctl = (gu32*)(args.ws + WS_CTL);
    for (int u = F.tid; u < (LDS_BYTES - LDSCTL_OFF) / 4; u += NWAVES * 64) ((LAS unsigned*)(F.lds + LDSCTL_OFF))[u] = 0u;
    __syncthreads();
    XcdBarrier bar; bar.bar = (unsigned*)(F.ctl + CW_BAR); bar.x = 0; bar.st = nullptr;
    if (N_LAUNCHES != PER_PHASE) bar = xcd_barrier_post((unsigned*)(F.ctl + CW_BAR), F.MISC + 8);
#define GRID_BAR(seam) do { if (N_LAUNCHES == PER_PHASE) { if (F.tid == 0) __hip_atomic_store(F.ctl + CW_TMO, 0xBADBA0u | (unsigned)(seam), RLX_AGENT); } else { xcd_barrier(bar); } } while (0)
    const int lo = args.ph_lo, hi = args.ph_hi;
#ifndef PH_MASK
#define PH_MASK 0x1ff
#endif
#define IN(k) (((PH_MASK >> (k)) & 1) && lo <= (k) && (k) < hi)
#define REP2(k, stmt) do { stmt; } while (0)
#define BOTH(k) (IN(k) && IN((k) + 1))

    if (IN(0)) { set_ptrs(F); REP2(0, p0_prologue(F)); if (BOTH(0)) GRID_BAR(0); }

    if (IN(1)) { set_ptrs(F);
        pg8::StaticOrder S; S.init(F.XN, F.WIN, M, INC, DM, F.G, (int)blockIdx.x);
        pg8::EpiBf16 E{F.PROJ, INC};
        REP2(1, (pg8::gemm_phase<pg8::EpiBf16, pg8::StaticOrder>(F.lds + RING_OFF, DM, S, E)));
        if (F.G == 256 && blockIdx.x >= 128) moe_items_wave(F, (((int)blockIdx.x - 128) * NWAVES + F.wave) * HID_P1, HID_P1);
        if (BOTH(1)) GRID_BAR(1);
    }

    if (IN(2)) { set_ptrs(F);
        unsigned char* ws_ = (unsigned char*)F.ctl;
        { const int u0 = F.vcu, nu = (NB * NH * (SEQ / 64) - u0 + F.G - 1) / F.G;
          const int w = F.wave; int lane = F.lane; asm volatile("" : "+v"(lane));
          unsigned qw[8], fw[8], iw[8];
          if (nu > 0) { const int bh = u0 & 31, ch = u0 >> 5; const bf16* Pq = F.PROJ + (size_t)(bh >> 3) * SEQ * INC + 3 * AW + (bh & 7) * HD; HP_LOAD(ch); }
          for (int k = 0; k < nu; ++k) { const int u = u0 + k * F.G, bh = u & 31, ch = u >> 5, b = bh >> 3, h = bh & 7; const int un = u + F.G, chn = (k + 1 < nu && (un & 31) == bh) ? (un >> 5) : -1;
            const bf16* Pq = F.PROJ + (size_t)b * SEQ * INC + 3 * AW + h * HD;
            if (k > 0 && ((u - F.G) & 31) != bh) HP_LOAD(ch);
            hg::hgrn_produce(Pq, F.lb_logits + h * HD, ws_ + WS_HIMG + (size_t)(bh * 32 + ch) * hg::IMG_BYTES, ws_ + WS_HOI + (size_t)(bh * 32 + ch) * hg::OI_BYTES, F.lds + RING_OFF, ch, chn, qw, fw, iw); } }
        if (BOTH(2)) GRID_BAR(2);
    }

    if (IN(3)) { set_ptrs(F);
        const int c = (int)blockIdx.x;
#define ATTN_ITEM(it) attn_item_mfma(F, (char*)lds + RING_OFF, it)
#define P2_HG() do { if (F.G == 256) { if (c < 32) HGRN_SCAN(c); } else { for (int it = c; it < NB * NH; it += F.G) HGRN_SCAN(it); } } while (0)
#define P2_AT() do { const bool lpt_ = (F.G == 256); const int n_ = lpt_ ? (c < 32 ? 0 : (c >= 224 ? 2 : 1)) : (NB * NH * MOBA_NB - c + F.G - 1) / F.G; \
        for (int k_ = 0; k_ < n_; ++k_) { const int it = lpt_ ? (k_ == 0 ? c - 32 : 224 + (255 - c)) : c + k_ * F.G; ATTN_ITEM(it); } } while (0)
#define P2_FIN() do { const bool lpt_ = (F.G == 256); const int cls_ = c < 32 ? 0 : 1 + ((c - 32) >> 5); \
        const int u0_ = lpt_ ? ((c < 32 ? c : (c - 32) & 31) + 32 * (int)((P3_FIN_PRE >> (8 * cls_)) & 255)) : c, nu_ = lpt_ ? (int)((P3_FIN >> (8 * cls_)) & 255) : (NB * NH * (SEQ / 64) - c + F.G - 1) / F.G, su_ = lpt_ ? 32 : F.G; \
        int last_bh_ = -1; \
        for (int k_ = 0; k_ < nu_; ++k_) { const int u = u0_ + k_ * su_, bh = u & 31, ch = u >> 5; \
            if (bh != last_bh_) { last_bh_ = bh; \
            if (F.tid == 0) { unsigned sp_ = 0; while (__hip_atomic_load(F.ctl + CW_HFLAG + 64 * bh, RLX_AGENT) == 0u && ++sp_ < (1u << 22)) __builtin_amdgcn_s_sleep(4); \
                __builtin_amdgcn_fence(__ATOMIC_ACQUIRE, "agent"); asm volatile("s_waitcnt vmcnt(0)" ::: "memory"); } \
            __syncthreads(); } \
            const unsigned char* ws_ = (const unsigned char*)F.ctl; \
            hg::hgrn_finish(ws_ + WS_HIMG + (size_t)(bh * 32 + ch) * hg::IMG_BYTES, ws_ + WS_HST + (size_t)(bh * 32 + ch) * hg::ST_BYTES, ws_ + WS_HOI + (size_t)(bh * 32 + ch) * hg::OI_BYTES, \
                F.PROJ + ((size_t)(bh >> 3) * SEQ + ch * 64) * INC + 3 * AW + (bh & 7) * HD + 3072, F.CAT + ((size_t)(bh >> 3) * SEQ + ch * 64) * DM + AW + (bh & 7) * HD, F.g_onorm, F.lds + RING_OFF); } } while (0)
#define HGRN_SCAN(it) do { hg::hgrn_scan((const unsigned char*)F.ctl + WS_HIMG + (size_t)(it) * 32 * hg::IMG_BYTES, (unsigned char*)F.ctl + WS_HST + (size_t)(it) * 32 * hg::ST_BYTES, F.lds + RING_OFF, SEQ / 64); \
        asm volatile("s_waitcnt vmcnt(0)" ::: "memory"); __syncthreads(); \
        if (F.tid == 0) { __builtin_amdgcn_fence(__ATOMIC_RELEASE, "agent"); asm volatile("s_waitcnt vmcnt(0)" ::: "memory"); __hip_atomic_store(F.ctl + CW_HFLAG + 64 * (it), 1u, RLX_AGENT); } } while (0)
#define P2_CVT() do { if (F.G == 256) { const int cls_ = c < 32 ? 0 : 1 + ((c - 32) >> 5), wg_ = c < 32 ? c : (c - 32) & 31; \
        const int cnt_ = (int)((P3_CVT >> (8 * cls_)) & 255), base_ = N_HID_P1 + 256 * (int)((P3_CVT_PRE >> (8 * cls_)) & 255); \
        if (cnt_ > 0) { __syncthreads(); moe_items_wave(F, base_ + (wg_ * NWAVES + F.wave) * cnt_, cnt_); } } } while (0)
#define P2_BODY() do { P2_HG(); P2_AT(); P2_CVT(); P2_FIN(); } while (0)
        REP2(3, P2_BODY());
        if (BOTH(3)) GRID_BAR(3);
    }

    if (IN(4)) { set_ptrs(F);
        pg8::StaticOrder S; S.init(F.CAT, F.WOUT, M, DM, DM, F.G, (int)blockIdx.x);
        pg8::EpiResBf16 E{F.x, (pg8::bf16_t*)F.X1, DM};
        REP2(4, (pg8::gemm_phase<pg8::EpiResBf16, pg8::StaticOrder>(F.lds + RING_OFF, DM, S, E)));
        if (BOTH(4)) GRID_BAR(4);
    }

    if (IN(5)) { set_ptrs(F); p4_router<false>(F); if (BOTH(5)) GRID_BAR(5); }
    if (IN(6)) { set_ptrs(F);
        LAS int* pre = (LAS int*)(F.lds + MISC_OFF + 64);
        load_prefix(F, pre);
        pg8::GroupedOrder S{pre[NE], F.G, (int)blockIdx.x, (const char*)F.XN, (const char*)F.WGU, (size_t)0, (size_t)256 * DM, (size_t)2048 * DM, (const PG8_LAS int*)pre, (const PG8_LAS int*)(pre + 32), F.ROWL, F.WL};
        LAS int* rowsL = (LAS int*)(F.lds + 131072);
        for (int i = 0; i < 16; ++i) { pg8::Unit u; if (!S.next(i, u)) break; if (F.tid < 256) rowsL[i * 256 + F.tid] = (F.tid < u.nvalid) ? (u.rows[F.tid] & 0xffff) : 0; }
        __syncthreads();
        pg8::EpiSwiGlu8 E{(unsigned char*)F.HID};
        REP2(6, (pg8::gemm_phase<pg8::EpiSwiGlu8, pg8::GroupedOrder, true, 0x7f7f7f7f, 0x79797979, true>(F.lds + RING_OFF, DM, S, E, (const PG8_LAS int*)rowsL)));
        if (F.G == 256) {
            const int U = pre[NE] * 8, nb = U - ((U - 1) / 256) * 256, nidle = 256 - nb, c = (int)blockIdx.x;
            __syncthreads();
            LAS float* scr = (LAS float*)(F.lds + RING_OFF + F.wave * 16384);
            if (nidle >= 32) { if (c >= nb) for (int i = (c - nb) * NWAVES + F.wave; i < N_HID_P7; i += nidle * NWAVES) moe_item(F, I_MOE - N_HID_P7 + i, scr, F.lane); }
            else for (int i = c * NWAVES + F.wave; i < N_HID_P7; i += 256 * NWAVES) moe_item(F, I_MOE - N_HID_P7 + i, scr, F.lane);
        }
        if (BOTH(6)) GRID_BAR(6);
    }

    if (IN(7)) { set_ptrs(F);
        LAS int* pre = (LAS int*)(F.lds + MISC_OFF + 64);
        load_prefix(F, pre);
        pg8::GroupedOrder S{pre[NE], F.G, (int)blockIdx.x, (const char*)F.HID, (const char*)F.WD, (size_t)256 * DE, (size_t)256 * DE, (size_t)DM * DE, (const PG8_LAS int*)pre, (const PG8_LAS int*)(pre + 32), F.ROWL, F.WL};
        pg8::EpiScatter E{F.Y};
        REP2(7, (pg8::gemm_phase<pg8::EpiScatter, pg8::GroupedOrder, true, 0x7d7d7d7d, 0x7a7a7a7a>(F.lds + RING_OFF, DE, S, E)));
        if (BOTH(7)) GRID_BAR(7);
    }

    if (IN(8)) { set_ptrs(F); REP2(8, p7_final(F)); }
#undef IN
#undef BOTH
}

extern "C" void kernel_launch(void* const* d_in, const int* in_sizes, int n_in, void* d_out, int out_size, void* d_ws, size_t ws_size, hipStream_t stream) {
    static int grid = 0;
    if (grid == 0) {
        if (n_in != 15 || in_sizes[0] != M * DM || out_size != M * DM || ws_size < 504 * MiB) { fprintf(stderr, "kernel_launch: unexpected shapes (n_in %d, in0 %d, out %d, ws %zu < %zu)\n", n_in, n_in > 0 ? in_sizes[0] : -1, out_size, ws_size, (size_t)WS_END); grid = -1; return; }
        int dev = 0, cus = 0, per_cu = 0;
        if (hipGetDevice(&dev) != hipSuccess || hipDeviceGetAttribute(&cus, hipDeviceAttributeMultiprocessorCount, dev) != hipSuccess) { grid = -1; return; }
        if (hipFuncSetAttribute((const void*)skel_fwd, hipFuncAttributeMaxDynamicSharedMemorySize, LDS_BYTES) != hipSuccess) { fprintf(stderr, "kernel_launch: hipFuncSetAttribute failed\n"); grid = -1; return; }
        if (hipOccupancyMaxActiveBlocksPerMultiprocessor(&per_cu, (const void*)skel_fwd, NWAVES * 64, LDS_BYTES) != hipSuccess || per_cu < 1) { fprintf(stderr, "kernel_launch: occupancy query says %d blocks per CU\n", per_cu); grid = -1; (void)hipGetLastError(); return; }
        grid = cus;
    }
    if (grid < 0) return;
    if (hipMemsetAsync((char*)d_ws + WS_CTL, 0, CTL_ZERO_BYTES, stream) != hipSuccess) return;
    Args a{};
    for (int i = 0; i < 15; ++i) a.in[i] = (const float*)d_in[i];
    a.out = (float*)d_out; a.ws = (unsigned char*)d_ws;
    for (int li = 0; li < N_LAUNCHES; ++li) {
        a.ph_lo = (N_LAUNCHES == PER_PHASE) ? li : 0; a.ph_hi = (N_LAUNCHES == PER_PHASE) ? li + 1 : PER_PHASE; a.li = li;
        hipLaunchKernelGGL(skel_fwd, dim3(grid), dim3(NWAVES * 64), LDS_BYTES, stream, a);
        if (N_LAUNCHES != PER_PHASE) break;
    }
}
```

```cpp
#include <hip/hip_runtime.h>
#include <cstdio>
#include <cstdint>

#ifndef MK_N_LAUNCHES
#define MK_N_LAUNCHES 1
#endif

template <int CTRL> __device__ __forceinline__ float xl_dpp(float v) { return __builtin_bit_cast(float, __builtin_amdgcn_update_dpp(0, __builtin_bit_cast(int, v), CTRL, 0xF, 0xF, true)); }
__device__ __forceinline__ float xl_xor1(float v) { return xl_dpp<0xB1>(v); }
__device__ __forceinline__ float xl_add16(float v) { const auto r = __builtin_amdgcn_permlane16_swap(__float_as_uint(v), __float_as_uint(v), false, false); const unsigned r0 = r[0], r1 = r[1]; return __uint_as_float(r0) + __uint_as_float(r1); }
__device__ __forceinline__ float xl_add32(float v) { const auto r = __builtin_amdgcn_permlane32_swap(__float_as_uint(v), __float_as_uint(v), false, false); const unsigned r0 = r[0], r1 = r[1]; return __uint_as_float(r0) + __uint_as_float(r1); }
__device__ __forceinline__ float xl_wave_sum(float v) {
    v += xl_dpp<0xB1>(v); v += xl_dpp<0x4E>(v);
    v += xl_dpp<0x141>(v); v += xl_dpp<0x140>(v);
    return xl_add32(xl_add16(v));
}
namespace pg8 {
#define PG8_LAS __attribute__((address_space(3)))
typedef unsigned short bf16_t;
typedef short bf16x8 __attribute__((ext_vector_type(8)));
typedef float f32x4 __attribute__((ext_vector_type(4)));
typedef unsigned u32x4 __attribute__((ext_vector_type(4)));
constexpr int BM = 256, BK = 64, HALF = 128, HTB = HALF * BK * 2, STAGE_BYTES = 8 * HTB, NXCD = 8, WGM = 8;

__host__ __device__ __forceinline__ int lds_chunk(int r, int ch) { return r * 128 + ((ch ^ ((r >> 1) & 7)) << 4); }
__host__ __device__ __forceinline__ void stage_rc(int b, int& R, int& C) { R = b / 128; const int chp = (b % 128) / 16, ch = chp ^ ((R >> 1) & 7); C = ch * 8; }
__host__ __device__ __forceinline__ int perm32(int rho) { const int n = rho >> 4, i = rho & 15; return 8 * (i >> 2) + 4 * n + (i & 3); }

struct Unit { int pm, pn, e; const char* a; const char* b; const int* rows; const float* wl; int nvalid; int ui; };

struct StaticOrder {
    int nM, nN, nwg, G, c, wgm; const char* A; const char* Bt; size_t tstep;
    __device__ void init(const void* A_, const void* Bt_, int M, int N, int K, int G_, int c_, int wgm_ = WGM) { nM = M / BM; nN = N / BM; nwg = nM * nN; G = G_; c = c_; wgm = wgm_; A = (const char*)A_; Bt = (const char*)Bt_; tstep = (size_t)BM * K * 2; }
    __device__ bool next(int i, Unit& u) const {
        const long L = (long)i * G + c; if (L >= nwg) return false;
        int wgid = (int)L; { const int q = nwg / NXCD, r = nwg % NXCD, xcd = wgid % NXCD, off = wgid / NXCD; wgid = (xcd < r ? xcd * (q + 1) : r * (q + 1) + (xcd - r) * q) + off; }
        const int nig = wgm * nN, gid = wgid / nig, fm = gid * wgm, gsz = (nM - fm) < wgm ? (nM - fm) : wgm;
        u.pm = fm + ((wgid % nig) % gsz); u.pn = (wgid % nig) / gsz; u.e = 0;
        u.a = A + (size_t)u.pm * tstep; u.b = Bt + (size_t)u.pn * tstep; u.rows = nullptr; u.wl = nullptr; u.nvalid = 256; return true;
    }
};
struct GroupedOrder {
    int ntile, G, c; const char* A; const char* Bt; size_t a_tstep, b_tstep, b_estep; const PG8_LAS int* pre; const PG8_LAS int* cnt; const int* rowl; const float* wlist;
    __device__ bool next(int i, Unit& u) const {
        const long L = (long)i * G + c; if (L >= (long)ntile * 8) return false;
        const int t = (int)(L >> 3), pn = (int)(L & 7); int e = 0;
#pragma unroll
        for (int j = 1; j < 16; ++j) e += (t >= pre[j]) ? 1 : 0;
        const int mt = t - pre[e];
        u.pm = t; u.pn = pn; u.e = e; u.a = A + (size_t)t * a_tstep; u.b = Bt + (size_t)e * b_estep + (size_t)pn * b_tstep;
        u.rows = rowl + e * 8192 + 256 * mt; u.wl = wlist + e * 8192 + 256 * mt; u.nvalid = cnt[e] - 256 * mt; return true;
    }
};

typedef float f32x2_c __attribute__((ext_vector_type(2))); typedef __bf16 bf16x2_c __attribute__((ext_vector_type(2)));
__device__ __forceinline__ unsigned cvt_pk_bf16(float lo, float hi) { const f32x2_c v = {lo, hi}; return __builtin_bit_cast(unsigned, __builtin_convertvector(v, bf16x2_c)); }

struct EpiBf16 {
    static constexpr bool PERM = true;
    bf16_t* O; int ldc;
    __device__ __forceinline__ void operator()(const f32x4 (&acc)[2][2][4][2], const Unit& u, int wr, int wc, int fr, int fq) const {
        const int row0 = u.pm * BM + wr * 64 + fr; const int col0 = u.pn * BM + wc * 32 + 8 * fq;
#pragma unroll
        for (int ai = 0; ai < 2; ++ai)
#pragma unroll
            for (int m = 0; m < 4; ++m) { bf16_t* rowp = O + (size_t)(row0 + ai * HALF + m * 16) * ldc + col0;
#pragma unroll
                for (int bj = 0; bj < 2; ++bj) { const f32x4 v0 = acc[ai][bj][m][0], v1 = acc[ai][bj][m][1];
                    u32x4 w; w.x = cvt_pk_bf16(v0[0], v0[1]); w.y = cvt_pk_bf16(v0[2], v0[3]); w.z = cvt_pk_bf16(v1[0], v1[1]); w.w = cvt_pk_bf16(v1[2], v1[3]);
                    *(u32x4*)(rowp + bj * HALF) = w; } }
    }
};
struct EpiResBf16 {
    static constexpr bool PERM = true;
    const float* base; bf16_t* O; int ldc;
    __device__ __forceinline__ void operator()(const f32x4 (&acc)[2][2][4][2], const Unit& u, int wr, int wc, int fr, int fq) const {
        const int row0 = u.pm * BM + wr * 64 + fr; const int col0 = u.pn * BM + wc * 32 + 8 * fq;
#pragma unroll
        for (int ai = 0; ai < 2; ++ai) {
            f32x4 bv[4][2][2];
#pragma unroll
            for (int m = 0; m < 4; ++m) { const float* bp = base + (size_t)(row0 + ai * HALF + m * 16) * ldc + col0;
#pragma unroll
                for (int bj = 0; bj < 2; ++bj) { bv[m][bj][0] = *(const f32x4*)(bp + bj * HALF); bv[m][bj][1] = *(const f32x4*)(bp + bj * HALF + 4); } }
            __builtin_amdgcn_sched_barrier(0);
#pragma unroll
            for (int m = 0; m < 4; ++m) { bf16_t* op = O + (size_t)(row0 + ai * HALF + m * 16) * ldc + col0;
#pragma unroll
                for (int bj = 0; bj < 2; ++bj) { const f32x4 v0 = acc[ai][bj][m][0] + bv[m][bj][0], v1 = acc[ai][bj][m][1] + bv[m][bj][1];
                    u32x4 w; w.x = cvt_pk_bf16(v0[0], v0[1]); w.y = cvt_pk_bf16(v0[2], v0[3]); w.z = cvt_pk_bf16(v1[0], v1[1]); w.w = cvt_pk_bf16(v1[2], v1[3]);
                    *(u32x4*)(op + bj * HALF) = w; } }
            __builtin_amdgcn_sched_barrier(0);
        }
    }
};
__device__ __forceinline__ float silu_f(float v) { return v * __builtin_amdgcn_rcpf(1.f + __builtin_amdgcn_exp2f(-1.4426950408889634f * v)); }
__device__ __forceinline__ unsigned pk4_fp8(float a, float b, float c, float d) { int w = __builtin_amdgcn_cvt_pk_fp8_f32(a, b, 0, false); w = __builtin_amdgcn_cvt_pk_fp8_f32(c, d, w, true); return (unsigned)w; }
struct EpiSwiGlu8 {
    static constexpr bool PERM = true;
    unsigned char* Hid;
    const PG8_LAS float* wlL;
    __device__ __forceinline__ void operator()(const f32x4 (&acc)[2][2][4][2], const Unit& u, int wr, int wc, int fr, int fq) const {
        const int row0 = u.pm * BM + wr * 64 + fr; const int col0 = u.pn * HALF + wc * 32 + 8 * fq;
        float wv[2][4];
#pragma unroll
        for (int ai = 0; ai < 2; ++ai)
#pragma unroll
            for (int m = 0; m < 4; ++m) { const int rl = wr * 64 + fr + ai * HALF + m * 16;
                if (u.ui < 8) wv[ai][m] = wlL[u.ui * 256 + rl];
                else wv[ai][m] = rl < u.nvalid ? 4.f * u.wl[rl] : 0.f; }
        __builtin_amdgcn_sched_barrier(0);
#pragma unroll
        for (int ai = 0; ai < 2; ++ai)
#pragma unroll
            for (int m = 0; m < 4; ++m) { const int row = row0 + ai * HALF + m * 16; const float w = wv[ai][m];
                const f32x4 g0 = acc[ai][0][m][0], g1 = acc[ai][0][m][1], u0 = acc[ai][1][m][0], u1 = acc[ai][1][m][1];
                float h[8];
#pragma unroll
                for (int j = 0; j < 4; ++j) { h[j] = __builtin_amdgcn_fmed3f(silu_f(g0[j]) * u0[j] * w, -440.f, 440.f); h[4 + j] = __builtin_amdgcn_fmed3f(silu_f(g1[j]) * u1[j] * w, -440.f, 440.f); }
                typedef unsigned u32x2_ __attribute__((ext_vector_type(2)));
                *(u32x2_*)(Hid + (size_t)row * 1024 + col0) = (u32x2_){pk4_fp8(h[0], h[1], h[2], h[3]), pk4_fp8(h[4], h[5], h[6], h[7])}; }
    }
};
struct EpiScatter {
    static constexpr bool PERM = true;
    bf16_t* Y;
    __device__ __forceinline__ void operator()(const f32x4 (&acc)[2][2][4][2], const Unit& u, int wr, int wc, int fr, int fq) const {
        const int row0 = u.pm * BM + wr * 64 + fr; const int col0 = u.pn * BM + wc * 32 + 8 * fq;
        int rv[2][4];
#pragma unroll
        for (int ai = 0; ai < 2; ++ai)
#pragma unroll
            for (int m = 0; m < 4; ++m) { const int rl = wr * 64 + fr + ai * HALF + m * 16; rv[ai][m] = rl < u.nvalid ? u.rows[rl] : -1; }
        __builtin_amdgcn_sched_barrier(0);
#pragma unroll
        for (int ai = 0; ai < 2; ++ai)
#pragma unroll
            for (int m = 0; m < 4; ++m) { const int ri = rv[ai][m];
                if (ri >= 0) { bf16_t* rowp = Y + ((size_t)(ri >> 16) * 8192 + (size_t)(ri & 0xffff)) * 2048 + col0;
#pragma unroll
                    for (int bj = 0; bj < 2; ++bj) { const f32x4 v0 = acc[ai][bj][m][0], v1 = acc[ai][bj][m][1];
                        u32x4 w; w.x = cvt_pk_bf16(v0[0], v0[1]); w.y = cvt_pk_bf16(v0[2], v0[3]); w.z = cvt_pk_bf16(v1[0], v1[1]); w.w = cvt_pk_bf16(v1[2], v1[3]);
                        *(u32x4*)(rowp + bj * HALF) = w; } } }
    }
};

typedef int i32x8 __attribute__((ext_vector_type(8)));
template <class Epi, class Sched, bool FP8 = false, int SCA = 0x7f7f7f7f, int SCB = 0x7f7f7f7f, bool GATHER = false>
__device__ __forceinline__ void gemm_phase(PG8_LAS unsigned char* lds, const int K, const Sched& S, const Epi& E, const PG8_LAS int* rowsL = nullptr) {
    const int tid = threadIdx.x, wid = __builtin_amdgcn_readfirstlane(tid >> 6), lane = tid & 63, wr = wid >> 2, wc = wid & 3, fr = lane & 15, fq = lane >> 4;
    const int Kb = FP8 ? K : 2 * K;
    const int nt = Kb / (BK * 2);
    unsigned voffA[2], voffB[2], CA[2]; int RA[2];
#pragma unroll
    for (int i = 0; i < 2; ++i) { int R, C; stage_rc(tid * 16 + i * 8192, R, C); const int Rb = Epi::PERM ? ((R & ~31) + perm32(R & 31)) : R;
        voffA[i] = (unsigned)(R * Kb + C * 2); voffB[i] = (unsigned)(Rb * Kb + C * 2); RA[i] = R; CA[i] = (unsigned)(C * 2); }
    unsigned vA0[2] = {0u, 0u}, vA1[2] = {0u, 0u}, vN0[2] = {0u, 0u}, vN1[2] = {0u, 0u};
#define PG8_ROWS(v0, v1, u_) do { _Pragma("unroll") for (int i_ = 0; i_ < 2; ++i_) { v0[i_] = (unsigned)rowsL[(u_) * 256 + RA[i_]] * (unsigned)Kb + CA[i_]; v1[i_] = (unsigned)rowsL[(u_) * 256 + 128 + RA[i_]] * (unsigned)Kb + CA[i_]; } } while (0)
#define PG8_STAGE_A(bufoff, gbase, h) do { if constexpr (GATHER) { if (h) PG8_STAGE(bufoff, gbase, vA1); else PG8_STAGE(bufoff, gbase, vA0); } else { PG8_STAGE(bufoff, (gbase) + (h) * hstep, voffA); } } while (0)
    const size_t kstep = (size_t)(BK * 2);
    const size_t hstep = (size_t)HALF * Kb;
    const unsigned ldsw = (unsigned)wid * 1024u;
    const int aoff0 = lds_chunk(wr * 64 + fr, fq), aoff1 = lds_chunk(wr * 64 + fr, 4 + fq), boff0 = lds_chunk(wc * 32 + fr, fq), boff1 = lds_chunk(wc * 32 + fr, 4 + fq);
#define PG8_SA(b, h) (((b) * 2 + (h)) * HTB)
#define PG8_SB(b, h) ((4 + (b) * 2 + (h)) * HTB)
#define PG8_STAGE(bufoff, gbase, voff) do { _Pragma("unroll") for (int _i = 0; _i < 2; ++_i) \
        __builtin_amdgcn_global_load_lds((const unsigned*)((const char*)(gbase) + (voff)[_i]), (PG8_LAS unsigned*)(lds + (bufoff) + ldsw + _i * 8192), 16, 0, 0); } while (0)
#define PG8_LD32(p0, p1) __builtin_shufflevector(*(const PG8_LAS u32x4*)(p0), *(const PG8_LAS u32x4*)(p1), 0, 1, 2, 3, 4, 5, 6, 7)
#define PG8_LDA(dst, b, h) do { if constexpr (FP8) { _Pragma("unroll") for (int m = 0; m < 4; ++m) dst##8[m] = __builtin_bit_cast(i32x8, PG8_LD32(lds + PG8_SA(b, h) + aoff0 + m * 2048, lds + PG8_SA(b, h) + aoff1 + m * 2048)); } \
        else { _Pragma("unroll") for (int m = 0; m < 4; ++m) { dst[m][0] = *(const PG8_LAS bf16x8*)(lds + PG8_SA(b, h) + aoff0 + m * 2048); dst[m][1] = *(const PG8_LAS bf16x8*)(lds + PG8_SA(b, h) + aoff1 + m * 2048); } } } while (0)
#define PG8_LDB(dst, b, h) do { if constexpr (FP8) { _Pragma("unroll") for (int n = 0; n < 2; ++n) dst##8[n] = __builtin_bit_cast(i32x8, PG8_LD32(lds + PG8_SB(b, h) + boff0 + n * 2048, lds + PG8_SB(b, h) + boff1 + n * 2048)); } \
        else { _Pragma("unroll") for (int n = 0; n < 2; ++n) { dst[n][0] = *(const PG8_LAS bf16x8*)(lds + PG8_SB(b, h) + boff0 + n * 2048); dst[n][1] = *(const PG8_LAS bf16x8*)(lds + PG8_SB(b, h) + boff1 + n * 2048); } } } while (0)
#define PG8_CAT8(x) __builtin_shufflevector(__builtin_bit_cast(u32x4, (x)[0]), __builtin_bit_cast(u32x4, (x)[1]), 0, 1, 2, 3, 4, 5, 6, 7)
#define PG8_MMA(ai, bj, At, Bt) do { __builtin_amdgcn_s_setprio(1); \
        if constexpr (FP8) { _Pragma("unroll") for (int m = 0; m < 4; ++m) _Pragma("unroll") for (int n = 0; n < 2; ++n) \
            asm volatile("s_nop 1\n\tv_mfma_scale_f32_16x16x128_f8f6f4 %0, %1, %2, %0, %3, %4 op_sel_hi:[0,0,0]" : "+v"(acc[ai][bj][m][n]) : "v"(Bt##8[n]), "v"(At##8[m]), "v"(scb_), "v"(sca_)); } \
        else { _Pragma("unroll") for (int m = 0; m < 4; ++m) _Pragma("unroll") for (int n = 0; n < 2; ++n) _Pragma("unroll") for (int k = 0; k < 2; ++k) \
            acc[ai][bj][m][n] = __builtin_amdgcn_mfma_f32_16x16x32_bf16(Bt[n][k], At[m][k], acc[ai][bj][m][n], 0, 0, 0); } \
        __builtin_amdgcn_s_setprio(0); } while (0)
#define PG8_WAIT_V(n) asm volatile("s_waitcnt vmcnt(" #n ")" ::: "memory")
#define PG8_WAIT_L(n) asm volatile("s_waitcnt lgkmcnt(" #n ")" ::: "memory")
#define PG8_BAR __builtin_amdgcn_s_barrier()
#define PG8_SCHED __builtin_amdgcn_sched_barrier(0)
    int sca_ = SCA, scb_ = SCB; asm volatile("" : "+v"(sca_), "+v"(scb_));
    Unit cur, nxt; int ui = 0;
    if (!S.next(0, cur)) return;
    cur.ui = 0;
    f32x4 acc[2][2][4][2];
#pragma unroll
    for (int a = 0; a < 2; ++a)
#pragma unroll
        for (int b = 0; b < 2; ++b)
#pragma unroll
            for (int m = 0; m < 4; ++m)
#pragma unroll
                for (int n = 0; n < 2; ++n) acc[a][b][m][n] = (f32x4){0.f, 0.f, 0.f, 0.f};
    bf16x8 At[4][2], B0[2][2], B1[2][2]; i32x8 At8[4], B08[2], B18[2];
    const char* cA = cur.a; const char* cB = cur.b;
    if constexpr (GATHER) { PG8_ROWS(vA0, vA1, 0); }
    PG8_STAGE(PG8_SB(0, 0), cB, voffB); PG8_STAGE(PG8_SB(0, 1), cB + hstep, voffB); PG8_STAGE_A(PG8_SA(0, 0), cA, 0); PG8_STAGE_A(PG8_SA(0, 1), cA, 1);
    if (wr == 1) PG8_BAR;
    PG8_WAIT_V(2); PG8_BAR;
    PG8_STAGE(PG8_SB(1, 0), cB + kstep, voffB); PG8_STAGE_A(PG8_SA(1, 0), cA + kstep, 0); PG8_STAGE(PG8_SB(1, 1), cB + hstep + kstep, voffB);
    PG8_WAIT_V(6); PG8_BAR;
    for (;;) {
        const bool has_next = S.next(ui + 1, nxt); nxt.ui = ui + 1;
        const char* nA = has_next ? nxt.a : cA; const char* nB = has_next ? nxt.b : cB;
        if constexpr (GATHER) { PG8_ROWS(vN0, vN1, has_next ? ui + 1 : ui); }
#pragma clang loop unroll(disable)
        for (int t = 0; t < nt; t += 2) {
            const bool last = (t == nt - 2);
            const char* a1 = cA + (size_t)(t + 1) * kstep;
            const char* a2 = last ? nA : cA + (size_t)(t + 2) * kstep; const char* b2 = last ? nB : cB + (size_t)(t + 2) * kstep;
            const char* a3 = a2 + kstep; const char* b3 = b2 + kstep;
            PG8_LDB(B0, 0, 0); PG8_LDB(B1, 0, 1); PG8_SCHED; PG8_LDA(At, 0, 0); PG8_STAGE_A(PG8_SA(1, 1), a1, 1);
            if constexpr (GATHER) { if (last) { vA0[0] = vN0[0]; vA0[1] = vN0[1]; vA1[0] = vN1[0]; vA1[1] = vN1[1]; } }
            PG8_WAIT_V(8); PG8_WAIT_L(0); PG8_BAR; PG8_MMA(0, 0, At, B0); PG8_MMA(0, 1, At, B1); PG8_BAR; PG8_SCHED;
            PG8_LDA(At, 0, 1); PG8_STAGE(PG8_SB(0, 0), b2, voffB); PG8_STAGE(PG8_SB(0, 1), b2 + hstep, voffB); PG8_STAGE_A(PG8_SA(0, 0), a2, 0);
            PG8_WAIT_V(8); PG8_WAIT_L(0); PG8_BAR; PG8_MMA(1, 0, At, B0); PG8_MMA(1, 1, At, B1); PG8_BAR; PG8_SCHED;
            PG8_LDB(B0, 1, 0); PG8_LDB(B1, 1, 1); PG8_SCHED; PG8_LDA(At, 1, 0); PG8_STAGE_A(PG8_SA(0, 1), a2, 1);
            PG8_WAIT_V(8); PG8_WAIT_L(0); PG8_BAR; PG8_MMA(0, 0, At, B0); PG8_MMA(0, 1, At, B1); PG8_BAR; PG8_SCHED;
            PG8_LDA(At, 1, 1); PG8_STAGE(PG8_SB(1, 0), b3, voffB); PG8_STAGE(PG8_SB(1, 1), b3 + hstep, voffB); PG8_STAGE_A(PG8_SA(1, 0), a3, 0);
            PG8_WAIT_V(8); PG8_WAIT_L(0); PG8_BAR; PG8_MMA(1, 0, At, B0); PG8_MMA(1, 1, At, B1); PG8_BAR; PG8_SCHED;
        }
        if (wr == 0) PG8_BAR;
        if constexpr (FP8) asm volatile("s_nop 15\n\ts_nop 15" ::: "memory");
        E(acc, cur, wr, wc, fr, fq);
        if (!has_next) break;
#pragma unroll
        for (int a = 0; a < 2; ++a)
#pragma unroll
            for (int b = 0; b < 2; ++b)
#pragma unroll
                for (int m = 0; m < 4; ++m)
#pragma unroll
                    for (int n = 0; n < 2; ++n) acc[a][b][m][n] = (f32x4){0.f, 0.f, 0.f, 0.f};
        cur = nxt; cA = nA; cB = nB; ++ui;
        if (wr == 1) PG8_BAR;
    }
    PG8_WAIT_V(0);
    PG8_BAR;
#undef PG8_SA
#undef PG8_SB
#undef PG8_STAGE
#undef PG8_STAGE_A
#undef PG8_ROWS
#undef PG8_LDA
#undef PG8_LD32
#undef PG8_LDB
#undef PG8_MMA
#undef PG8_CAT8
#undef PG8_WAIT_V
#undef PG8_WAIT_L
#undef PG8_BAR
#undef PG8_SCHED
}
}

namespace moba {
typedef short bf16x8 __attribute__((ext_vector_type(8)));
typedef short s16x4 __attribute__((ext_vector_type(4)));
typedef float f32x16 __attribute__((ext_vector_type(16)));
typedef float f32x4 __attribute__((ext_vector_type(4)));
typedef unsigned u32x4 __attribute__((ext_vector_type(4)));
typedef unsigned short bf16;
constexpr int NW = 8, QBLK = 32, KVBLK = 64, QB = NW * QBLK, D = 128;
constexpr int SHM_V = KVBLK * D * 2, SHM_K = KVBLK * D * 2;
constexpr int LDS_WS = 2 * SHM_V + 2 * SHM_K, LDS_KM = LDS_WS + NW * 64 * 4, LDS_END = LDS_KM + 8 * 128 * 4;
constexpr float SCALE = 0.08838834764831845f, THR = 8.f;
constexpr int QP = 7168, OP = 2048;
#define KSWZ(row, colB) ((row) * 256 + ((colB) ^ (((row) & 7) << 4)))
#define SBAR() __builtin_amdgcn_sched_barrier(0)
__device__ __forceinline__ int v_st(int k, int c) { const int kk = (k & ~0xC) | ((k & 4) << 1) | ((k & 8) >> 1); return ((kk >> 3) * 4 + (c >> 5)) * 512 + ((kk & 7) * 32 + (c & 31)) * 2; }
__device__ __forceinline__ int v_rd_base(int lane) { return ((lane & 3) << 3) | (((lane >> 2) & 3) << 6) | (((lane >> 4) & 1) << 5) | (((lane >> 5) & 1) << 8); }
constexpr int v_rd_off(int d0, int ks, int half) { return d0 * 512 + ks * 4096 + half * 2048; }
__device__ __forceinline__ int crow(int r, int hi) { return (r & 3) + 8 * (r >> 2) + 4 * hi; }
typedef float f32x2_m __attribute__((ext_vector_type(2))); typedef __bf16 bf16x2_m __attribute__((ext_vector_type(2)));
__device__ __forceinline__ unsigned cvtpk(float lo, float hi) { const f32x2_m v = {lo, hi}; return __builtin_bit_cast(unsigned, __builtin_convertvector(v, bf16x2_m)); }
__device__ __forceinline__ bf16x8 load8(const bf16* p) { return *reinterpret_cast<const bf16x8*>(p); }
__device__ __forceinline__ void mask_tile(f32x16& p0, f32x16& p1, int dq) {
    const float NEG = -__builtin_inff();
#pragma unroll
    for (int r = 0; r < 16; ++r) { const int c = (r & 3) + 8 * (r >> 2); if (dq - c < 0) p0[r] = NEG; if (dq - c - 32 < 0) p1[r] = NEG; }
}
__device__ __forceinline__ void partialSM(f32x16& p0, f32x16& p1, float& m_reg, float& mn, float& alpha) {
    float pmax = p0[0]; for (int r = 1; r < 16; ++r) pmax = fmaxf(pmax, p0[r]); for (int r = 0; r < 16; ++r) pmax = fmaxf(pmax, p1[r]);
    { auto rr = __builtin_amdgcn_permlane32_swap(__float_as_uint(pmax), __float_as_uint(pmax), false, false);
      pmax = fmaxf(__uint_as_float(rr[0]), __uint_as_float(rr[1])); }
    constexpr float C2 = 1.4426950408889634f * SCALE;
    if (__builtin_expect(__all((pmax - m_reg) * SCALE <= THR), 1)) { mn = m_reg; alpha = 1.f; }
    else { mn = fmaxf(m_reg, pmax); alpha = __builtin_amdgcn_exp2f((m_reg - mn) * C2); m_reg = mn; }
    const float mnL = -mn * C2;
    for (int r = 0; r < 16; ++r) p0[r] = fmaf(p0[r], C2, mnL); for (int r = 0; r < 16; ++r) p1[r] = fmaf(p1[r], C2, mnL);
    for (int r = 0; r < 16; ++r) p0[r] = __builtin_amdgcn_exp2f(p0[r]);
}
__device__ __forceinline__ void finishSM(f32x16& p0, f32x16& p1, float alpha, float& l_reg, bf16x8& pa0, bf16x8& pa1, bf16x8& pa2, bf16x8& pa3) {
    for (int r = 0; r < 16; ++r) p1[r] = __builtin_amdgcn_exp2f(p1[r]);
    float ps = 0; for (int r = 0; r < 16; ++r) ps += p0[r]; for (int r = 0; r < 16; ++r) ps += p1[r];
    { auto rr = __builtin_amdgcn_permlane32_swap(__float_as_uint(ps), __float_as_uint(ps), false, false);
      ps = __uint_as_float(rr[0]) + __uint_as_float(rr[1]); }
    l_reg = l_reg * alpha + ps;
#define PK4(P, B_, OUT) do { unsigned a0 = cvtpk(P[B_+0], P[B_+1]), a1 = cvtpk(P[B_+2], P[B_+3]);                          \
        unsigned b0 = cvtpk(P[B_+4], P[B_+5]), b1 = cvtpk(P[B_+6], P[B_+7]);                                             \
        auto r0 = __builtin_amdgcn_permlane32_swap(a0, b0, false, false); auto r1 = __builtin_amdgcn_permlane32_swap(a1, b1, false, false); \
        u32x4 w = {r0[0], r1[0], r0[1], r1[1]}; OUT = *reinterpret_cast<bf16x8*>(&w); } while (0)
    PK4(p0, 0, pa0); PK4(p0, 8, pa1); PK4(p1, 0, pa2); PK4(p1, 8, pa3);
#undef PK4
}
template <int KB>
__device__ __forceinline__ void qkt(f32x16& p0, f32x16& p1, const char* K_lds, int r32, int hi, const bf16x8* qr, float base, float beta) {
    { const float b1 = beta, b2 = beta + beta, b3 = b2 + beta, b8 = 8.f * beta, b32 = 32.f * beta;
      p0[0] = base; p0[1] = base + b1; p0[2] = base + b2; p0[3] = base + b3;
#pragma unroll
      for (int r = 4; r < 16; ++r) p0[r] = p0[r - 4] + b8;
#pragma unroll
      for (int r = 0; r < 16; ++r) p1[r] = p0[r] + b32; }
    const char* kb[4];
#pragma unroll
    for (int dd = 0; dd < 4; ++dd) kb[dd] = K_lds + KB * SHM_K + KSWZ(r32, (dd * 16 + hi * 8) * 2);
#pragma unroll
    for (int d0 = 0; d0 < 8; ++d0) { const char* a = kb[d0 & 3] + (d0 >> 2) * 128;
        bf16x8 b0 = *reinterpret_cast<const bf16x8*>(a);
        bf16x8 b1 = *reinterpret_cast<const bf16x8*>(a + 32 * 256);
        p0 = __builtin_amdgcn_mfma_f32_32x32x16_bf16(b0, qr[d0], p0, 0, 0, 0);
        p1 = __builtin_amdgcn_mfma_f32_32x32x16_bf16(b1, qr[d0], p1, 0, 0, 0); }
}
template <int VB>
__device__ __forceinline__ void pv_tile(f32x16* o, int vb0, bf16x8 pa0, bf16x8 pa1, bf16x8 pa2, bf16x8 pa3) {
#define TRRD(dst, off) asm volatile("ds_read_b64_tr_b16 %0, %1 offset:%2" : "=&v"(dst) : "v"(vb0), "i"(off) : "memory")
#define PV_D0(d0) do { s16x4 l0, l1, l2, l3, h0, h1, h2, h3; constexpr int b_ = VB * SHM_V + v_rd_off(d0, 0, 0); \
        TRRD(l0, b_); TRRD(h0, b_ + 2048); TRRD(l1, b_ + 4096); TRRD(h1, b_ + 6144); TRRD(l2, b_ + 8192); TRRD(h2, b_ + 10240); TRRD(l3, b_ + 12288); TRRD(h3, b_ + 14336); \
        asm volatile("s_waitcnt lgkmcnt(0)" ::: "memory"); SBAR();   \
        o[d0] = __builtin_amdgcn_mfma_f32_32x32x16_bf16(pa0, (bf16x8){l0[0], l0[1], l0[2], l0[3], h0[0], h0[1], h0[2], h0[3]}, o[d0], 0, 0, 0);   \
        o[d0] = __builtin_amdgcn_mfma_f32_32x32x16_bf16(pa1, (bf16x8){l1[0], l1[1], l1[2], l1[3], h1[0], h1[1], h1[2], h1[3]}, o[d0], 0, 0, 0);   \
        o[d0] = __builtin_amdgcn_mfma_f32_32x32x16_bf16(pa2, (bf16x8){l2[0], l2[1], l2[2], l2[3], h2[0], h2[1], h2[2], h2[3]}, o[d0], 0, 0, 0);   \
        o[d0] = __builtin_amdgcn_mfma_f32_32x32x16_bf16(pa3, (bf16x8){l3[0], l3[1], l3[2], l3[3], h3[0], h3[1], h3[2], h3[3]}, o[d0], 0, 0, 0); } while (0)
    PV_D0(0); PV_D0(1); PV_D0(2); PV_D0(3);
#undef PV_D0
#undef TRRD
}
constexpr int R_V = 0, R_K = 3 * SHM_V, R_WS = R_K + 3 * SHM_K, R_KM = R_WS + NW * 64 * 4, R_END = R_KM + 8 * 128 * 4;
__device__ __forceinline__ void qkt_r(f32x16& p0, f32x16& p1, const char* Kslot, int r32, int hi, const bf16x8* qr, float base, float beta) {
    { const float b1 = beta, b2 = beta + beta, b3 = b2 + beta, b8 = 8.f * beta, b32 = 32.f * beta;
      p0[0] = base; p0[1] = base + b1; p0[2] = base + b2; p0[3] = base + b3;
#pragma unroll
      for (int r = 4; r < 16; ++r) p0[r] = p0[r - 4] + b8;
#pragma unroll
      for (int r = 0; r < 16; ++r) p1[r] = p0[r] + b32; }
    const char* kb[4];
#pragma unroll
    for (int dd = 0; dd < 4; ++dd) kb[dd] = Kslot + KSWZ(r32, (dd * 16 + hi * 8) * 2);
#pragma unroll
    for (int d0 = 0; d0 < 8; ++d0) { const char* a = kb[d0 & 3] + (d0 >> 2) * 128;
        bf16x8 b0 = *reinterpret_cast<const bf16x8*>(a);
        bf16x8 b1 = *reinterpret_cast<const bf16x8*>(a + 32 * 256);
        p0 = __builtin_amdgcn_mfma_f32_32x32x16_bf16(b0, qr[d0], p0, 0, 0, 0);
        p1 = __builtin_amdgcn_mfma_f32_32x32x16_bf16(b1, qr[d0], p1, 0, 0, 0); }
}
__device__ __forceinline__ void pv_tile_r(f32x16* o, int vbs  , bf16x8 pa0, bf16x8 pa1, bf16x8 pa2, bf16x8 pa3) {
#define TRRD(dst, off) asm volatile("ds_read_b64_tr_b16 %0, %1 offset:%2" : "=&v"(dst) : "v"(vbs), "i"(off) : "memory")
#define PV_D0(d0) do { s16x4 l0, l1, l2, l3, h0, h1, h2, h3; constexpr int b_ = v_rd_off(d0, 0, 0); \
        TRRD(l0, b_); TRRD(h0, b_ + 2048); TRRD(l1, b_ + 4096); TRRD(h1, b_ + 6144); TRRD(l2, b_ + 8192); TRRD(h2, b_ + 10240); TRRD(l3, b_ + 12288); TRRD(h3, b_ + 14336); \
        asm volatile("s_waitcnt lgkmcnt(0)" ::: "memory"); SBAR();   \
        o[d0] = __builtin_amdgcn_mfma_f32_32x32x16_bf16(pa0, (bf16x8){l0[0], l0[1], l0[2], l0[3], h0[0], h0[1], h0[2], h0[3]}, o[d0], 0, 0, 0);   \
        o[d0] = __builtin_amdgcn_mfma_f32_32x32x16_bf16(pa1, (bf16x8){l1[0], l1[1], l1[2], l1[3], h1[0], h1[1], h1[2], h1[3]}, o[d0], 0, 0, 0);   \
        o[d0] = __builtin_amdgcn_mfma_f32_32x32x16_bf16(pa2, (bf16x8){l2[0], l2[1], l2[2], l2[3], h2[0], h2[1], h2[2], h2[3]}, o[d0], 0, 0, 0);   \
        o[d0] = __builtin_amdgcn_mfma_f32_32x32x16_bf16(pa3, (bf16x8){l3[0], l3[1], l3[2], l3[3], h3[0], h3[1], h3[2], h3[3]}, o[d0], 0, 0, 0); } while (0)
    PV_D0(0); PV_D0(1); PV_D0(2); PV_D0(3);
#undef PV_D0
#undef TRRD
}
__device__ __forceinline__ void moba_unit_ring(const bf16* Q, const bf16* Kh, const bf16* Vh, bf16* O, int qb, float beta, char* lds) {
    int tid = threadIdx.x; asm volatile("" : "+v"(tid));
    const int wid = __builtin_amdgcn_readfirstlane(tid >> 6), lane = tid & 63, r32 = lane & 31, hi = lane >> 5;
    char* V_lds = lds + R_V; char* K_lds = lds + R_K;
    float* ws = (float*)(lds + R_WS) + wid * 64; float* al_l = ws + 32;
    float* km = (float*)(lds + R_KM);
    const int P0 = qb * QB, NT = 4 * (qb + 1);
    const int sr = tid >> 4, sc = (tid & 15) * 8, vst0 = v_st(sr, sc), vst1 = v_st(32 + sr, sc), kws = KSWZ(sr, sc * 2);
    const int vb0 = (int)(uintptr_t)V_lds + v_rd_base(lane);
    bf16x8 qr[8]; bf16x8 st_v0, st_v1, st_k0, st_k1;
#define ROW(p, k0, rr) ((p) + (size_t)((k0) + (rr)) * QP + sc)
#define VMW() asm volatile("s_waitcnt vmcnt(0)" ::: "memory")
#define SLOAD_H(k0) do { st_v0 = load8(ROW(Vh, k0, sr)); st_v1 = load8(ROW(Vh, k0, 32 + sr)); st_k0 = load8(ROW(Kh, k0, sr)); st_k1 = load8(ROW(Kh, k0, 32 + sr)); } while (0)
#define SWRITE_R(off) do { *(bf16x8*)(V_lds + (off) + vst0) = st_v0; *(bf16x8*)(V_lds + (off) + vst1) = st_v1; *(bf16x8*)(K_lds + (off) + kws) = st_k0; *(bf16x8*)(K_lds + (off) + kws + 32 * 256) = st_k1; } while (0)
    __syncthreads();
    SLOAD_H(0);
#pragma unroll
    for (int d0 = 0; d0 < 8; ++d0) qr[d0] = load8(Q + (size_t)(P0 + wid * QBLK + r32) * QP + d0 * 16 + hi * 8);
    if (wid < qb) {
        const int dg = lane & 15, rg = lane >> 4; const bf16* kp = Kh + (size_t)(wid * 256 + rg) * QP + 8 * dg;
        float s[8];
#pragma unroll
        for (int i = 0; i < 8; ++i) s[i] = 0.f;
#pragma unroll 16
        for (int j = 0; j < 64; ++j) { const u32x4 w = *(const u32x4*)(kp + (size_t)(4 * j) * QP);
            s[0] += __uint_as_float(w.x << 16); s[1] += __uint_as_float(w.x & 0xffff0000u); s[2] += __uint_as_float(w.y << 16); s[3] += __uint_as_float(w.y & 0xffff0000u);
            s[4] += __uint_as_float(w.z << 16); s[5] += __uint_as_float(w.z & 0xffff0000u); s[6] += __uint_as_float(w.w << 16); s[7] += __uint_as_float(w.w & 0xffff0000u); }
#pragma unroll
        for (int i = 0; i < 8; ++i) s[i] = xl_add32(xl_add16(s[i])) * (1.f / 256.f);
        if (rg == 0) { *(f32x4*)(km + wid * 128 + 8 * dg) = (f32x4){s[0], s[1], s[2], s[3]}; *(f32x4*)(km + wid * 128 + 8 * dg + 4) = (f32x4){s[4], s[5], s[6], s[7]}; } }
    VMW(); SWRITE_R(0);
    SLOAD_H(KVBLK);
    asm volatile("s_waitcnt lgkmcnt(0)" ::: "memory"); __builtin_amdgcn_s_barrier(); asm volatile("" ::: "memory");
    unsigned selbits = (1u << qb) - 1u;
    if (qb > 3) { float gt[8];
#pragma unroll
        for (int n = 0; n < 8; ++n) { float a = 0.f;
            if (n < qb) {
#pragma unroll
                for (int d0 = 0; d0 < 8; ++d0) { const f32x4 k0 = *(const f32x4*)(km + n * 128 + d0 * 16 + hi * 8), k1 = *(const f32x4*)(km + n * 128 + d0 * 16 + hi * 8 + 4); const bf16x8 q = qr[d0];
                    a += __uint_as_float((unsigned)(unsigned short)q[0] << 16) * k0[0] + __uint_as_float((unsigned)(unsigned short)q[1] << 16) * k0[1] + __uint_as_float((unsigned)(unsigned short)q[2] << 16) * k0[2] + __uint_as_float((unsigned)(unsigned short)q[3] << 16) * k0[3]
                       + __uint_as_float((unsigned)(unsigned short)q[4] << 16) * k1[0] + __uint_as_float((unsigned)(unsigned short)q[5] << 16) * k1[1] + __uint_as_float((unsigned)(unsigned short)q[6] << 16) * k1[2] + __uint_as_float((unsigned)(unsigned short)q[7] << 16) * k1[3]; }
                a = xl_add32(a); }
            gt[n] = (n < qb) ? a : -__builtin_inff(); }
        selbits = 0u;
#pragma unroll
        for (int k = 0; k < 3; ++k) { float best = -__builtin_inff(); int bi = 0;
#pragma unroll
            for (int n = 0; n < 8; ++n) { const bool take = !((selbits >> n) & 1u) && gt[n] > best; best = take ? gt[n] : best; bi = take ? n : bi; }
            selbits |= 1u << bi; } }
    selbits |= 1u << qb;
    const int qlo = P0 + wid * QBLK, qm = qlo + r32 - 4 * hi;
    float m_reg = -1e30f, l_reg = 0; f32x16 o[4] = {};
#define RESC(a) do { if (__any((a) < 1.f)) { if (hi == 0) al_l[r32] = (a); asm volatile("s_waitcnt lgkmcnt(0)" ::: "memory");              \
                     for (int d_ = 0; d_ < 4; ++d_) for (int r = 0; r < 16; ++r) o[d_][r] *= al_l[crow(r, hi)]; } } while (0)
#define KBASE(t) ((t) * KVBLK)
#define BASE(t) (((selbits >> ((t) >> 2)) & 1u) ? beta * (float)(KBASE(t) - P0 + 4 * hi) : -__builtin_inff())
#define MASKT(P0_, P1_, t) do { const int kb_ = KBASE(t); if (kb_ + KVBLK - 1 > qlo) mask_tile(P0_, P1_, qm - kb_); } while (0)
    f32x16 pA0, pA1, pB0, pB1; float mnA, mnB, alA, alB; bf16x8 pa0, pa1, pa2, pa3;
    int s_prv = 2 * SHM_K, s_cur = 0, s_nxt = SHM_K;
#define ROT() do { const int o_ = s_prv; s_prv = s_cur; s_cur = s_nxt; s_nxt = o_; } while (0)
    SBAR(); qkt_r(pA0, pA1, K_lds + s_cur, r32, hi, qr, BASE(0), beta);
    VMW(); SWRITE_R(s_nxt); SBAR(); SLOAD_H(KBASE(2)); SBAR();
    MASKT(pA0, pA1, 0); partialSM(pA0, pA1, m_reg, mnA, alA); RESC(alA);
    __syncthreads(); ROT();
#define STEP(PX0, PX1, mnX, alX, PY0, PY1, alY, t) do {                                                                         \
        SBAR(); qkt_r(PX0, PX1, K_lds + s_cur, r32, hi, qr, BASE(t), beta);                                                     \
        finishSM(PY0, PY1, alY, l_reg, pa0, pa1, pa2, pa3); SBAR();                                                             \
        if ((t) + 1 < NT) { VMW(); SWRITE_R(s_nxt); SBAR(); if ((t) + 2 < NT) { SLOAD_H(KBASE((t) + 2)); SBAR(); } }            \
        pv_tile_r(o, vb0 + s_prv, pa0, pa1, pa2, pa3); MASKT(PX0, PX1, (t)); partialSM(PX0, PX1, m_reg, mnX, alX);              \
        RESC(alX); __syncthreads(); ROT(); } while (0)
    for (int t = 1; t + 1 < NT; t += 2) {
        STEP(pB0, pB1, mnB, alB, pA0, pA1, alA, t);
        STEP(pA0, pA1, mnA, alA, pB0, pB1, alB, t + 1);
    }
    STEP(pB0, pB1, mnB, alB, pA0, pA1, alA, NT - 1);
    finishSM(pB0, pB1, alB, l_reg, pa0, pa1, pa2, pa3); SBAR(); pv_tile_r(o, vb0 + s_prv, pa0, pa1, pa2, pa3);
    { int t2 = threadIdx.x; asm volatile("" : "+v"(t2)); const int r32e = t2 & 31, hie = (t2 >> 5) & 1;
      float* wse = (float*)(lds + R_WS) + wid * 64;
      if (hie == 0) wse[r32e] = l_reg; asm volatile("s_waitcnt lgkmcnt(0)" ::: "memory");
      bf16* Ow = O + (size_t)(P0 + wid * QBLK) * OP + r32e;
#pragma unroll
      for (int r = 0; r < 16; ++r) { const int orow = crow(r, hie); const float rl = __builtin_amdgcn_rcpf(wse[orow]);
#pragma unroll
        for (int d0 = 0; d0 < 4; ++d0) { const float v = o[d0][r] * rl; const float vn = xl_xor1(v);
            if ((r32e & 1) == 0) *(unsigned*)(Ow + (size_t)orow * OP + d0 * 32) = cvtpk(v, vn); } } }
#undef RESC
#undef KBASE
#undef BASE
#undef MASKT
#undef STEP
#undef ROT
#undef ROW
#undef VMW
#undef SLOAD_H
#undef SWRITE_R
}
__device__ __forceinline__ void moba_unit(const bf16* Q, const bf16* Kh, const bf16* Vh, bf16* O, int qb, float beta, char* lds) {
    int tid = threadIdx.x; asm volatile("" : "+v"(tid));
    const int wid = __builtin_amdgcn_readfirstlane(tid >> 6), lane = tid & 63, r32 = lane & 31, hi = lane >> 5;
    char* V_lds = lds; char* K_lds = lds + 2 * SHM_V;
    float* ws = (float*)(lds + LDS_WS) + wid * 64; float* li_l = ws, * al_l = ws + 32;
    float* km = (float*)(lds + LDS_KM);
    const int P0 = qb * QB, NT = 4 * (qb + 1);
    const int sr = tid >> 4, sc = (tid & 15) * 8, vst0 = v_st(sr, sc), vst1 = v_st(32 + sr, sc), kws = KSWZ(sr, sc * 2);
    const int vb0 = (int)(uintptr_t)V_lds + v_rd_base(lane);
    bf16x8 qr[8]; bf16x8 st_v0, st_v1, st_k0, st_k1;
#define ROW(p, k0, rr) ((p) + (size_t)((k0) + (rr)) * QP + sc)
#define VMW() asm volatile("s_waitcnt vmcnt(0)" ::: "memory")
#define SLOAD_H(k0) do { st_v0 = load8(ROW(Vh, k0, sr)); st_v1 = load8(ROW(Vh, k0, 32 + sr)); st_k0 = load8(ROW(Kh, k0, sr)); st_k1 = load8(ROW(Kh, k0, 32 + sr)); } while (0)
#define SWRITE_HK(bf) do { *(bf16x8*)(K_lds + (bf) * SHM_K + kws) = st_k0; *(bf16x8*)(K_lds + (bf) * SHM_K + kws + 32 * 256) = st_k1; } while (0)
#define SWRITE_HV(bf) do { *(bf16x8*)(V_lds + (bf) * SHM_V + vst0) = st_v0; *(bf16x8*)(V_lds + (bf) * SHM_V + vst1) = st_v1; } while (0)
#define SWRITE_H(bf) do { SWRITE_HV(bf); SWRITE_HK(bf); } while (0)
    __syncthreads();
    if (wid < qb) { float s0 = 0.f, s1 = 0.f; const bf16* kp = Kh + (size_t)(wid * 256) * QP + 2 * lane;
#pragma unroll 8
        for (int j = 0; j < 256; ++j) { const unsigned w = *(const unsigned*)(kp + (size_t)j * QP); s0 += __uint_as_float(w << 16); s1 += __uint_as_float(w & 0xffff0000u); }
        km[wid * 128 + 2 * lane] = s0 * (1.f / 256.f); km[wid * 128 + 2 * lane + 1] = s1 * (1.f / 256.f); }
#pragma unroll
    for (int d0 = 0; d0 < 8; ++d0) qr[d0] = load8(Q + (size_t)(P0 + wid * QBLK + r32) * QP + d0 * 16 + hi * 8);
    SLOAD_H(0); VMW(); SWRITE_HK(0);
    __syncthreads();
    unsigned selbits = (1u << qb) - 1u;
    if (qb > 3) { float gt[8];
#pragma unroll
        for (int n = 0; n < 8; ++n) { float a = 0.f;
            if (n < qb) {
#pragma unroll
                for (int d0 = 0; d0 < 8; ++d0) { const f32x4 k0 = *(const f32x4*)(km + n * 128 + d0 * 16 + hi * 8), k1 = *(const f32x4*)(km + n * 128 + d0 * 16 + hi * 8 + 4); const bf16x8 q = qr[d0];
                    a += __uint_as_float((unsigned)(unsigned short)q[0] << 16) * k0[0] + __uint_as_float((unsigned)(unsigned short)q[1] << 16) * k0[1] + __uint_as_float((unsigned)(unsigned short)q[2] << 16) * k0[2] + __uint_as_float((unsigned)(unsigned short)q[3] << 16) * k0[3]
                       + __uint_as_float((unsigned)(unsigned short)q[4] << 16) * k1[0] + __uint_as_float((unsigned)(unsigned short)q[5] << 16) * k1[1] + __uint_as_float((unsigned)(unsigned short)q[6] << 16) * k1[2] + __uint_as_float((unsigned)(unsigned short)q[7] << 16) * k1[3]; }
                a = xl_add32(a); }
            gt[n] = (n < qb) ? a : -__builtin_inff(); }
        selbits = 0u;
#pragma unroll
        for (int k = 0; k < 3; ++k) { float best = -__builtin_inff(); int bi = 0;
#pragma unroll
            for (int n = 0; n < 8; ++n) { const bool take = !((selbits >> n) & 1u) && gt[n] > best; best = take ? gt[n] : best; bi = take ? n : bi; }
            selbits |= 1u << bi; } }
    selbits |= 1u << qb;
    const int qlo = P0 + wid * QBLK, qm = qlo + r32 - 4 * hi;
    float m_reg = -1e30f, l_reg = 0; f32x16 o[4] = {};
#define RESC(a) do { if (__any((a) < 1.f)) { if (hi == 0) al_l[r32] = (a); asm volatile("s_waitcnt lgkmcnt(0)" ::: "memory");              \
                     for (int d_ = 0; d_ < 4; ++d_) for (int r = 0; r < 16; ++r) o[d_][r] *= al_l[crow(r, hi)]; } } while (0)
#define KBASE(t) ((t) * KVBLK)
#define BASE(t) (((selbits >> ((t) >> 2)) & 1u) ? beta * (float)(KBASE(t) - P0 + 4 * hi) : -__builtin_inff())
#define MASKT(P0_, P1_, t) do { const int kb_ = KBASE(t); if (kb_ + KVBLK - 1 > qlo) mask_tile(P0_, P1_, qm - kb_); } while (0)
    f32x16 pA0, pA1, pB0, pB1; float mnA, mnB, alA, alB; bf16x8 pa0, pa1, pa2, pa3;
    SWRITE_HV(0); SBAR();
    if (NT > 1) SLOAD_H(KBASE(1));
    SBAR(); qkt<0>(pA0, pA1, K_lds, r32, hi, qr, BASE(0), beta);
    MASKT(pA0, pA1, 0); partialSM(pA0, pA1, m_reg, mnA, alA);
    if (NT > 1) { VMW(); SWRITE_H(1); }
    __syncthreads();
#define HALF_STEP(PX0, PX1, mnX, alX, PY0, PY1, alY, t, KB, VB, SB) do {                                                      \
        SBAR(); qkt<KB>(PX0, PX1, K_lds, r32, hi, qr, BASE(t), beta);                                                         \
        finishSM(PY0, PY1, alY, l_reg, pa0, pa1, pa2, pa3); SBAR();                                                           \
        if ((t) + 1 < NT) { SLOAD_H(KBASE((t) + 1)); SBAR(); }                                                                \
        pv_tile<VB>(o, vb0, pa0, pa1, pa2, pa3); MASKT(PX0, PX1, (t)); partialSM(PX0, PX1, m_reg, mnX, alX);                  \
        __syncthreads();                                                                                                      \
        if ((t) + 1 < NT) { VMW(); SWRITE_H(SB); }                                                                            \
        RESC(alX); __syncthreads(); } while (0)
    for (int t = 1; t + 1 < NT; t += 2) {
        HALF_STEP(pB0, pB1, mnB, alB, pA0, pA1, alA, t, 1, 0, 0);
        HALF_STEP(pA0, pA1, mnA, alA, pB0, pB1, alB, t + 1, 0, 1, 1);
    }
    SBAR(); qkt<1>(pB0, pB1, K_lds, r32, hi, qr, BASE(NT - 1), beta); SBAR();
    finishSM(pA0, pA1, alA, l_reg, pa0, pa1, pa2, pa3); SBAR();
    pv_tile<0>(o, vb0, pa0, pa1, pa2, pa3);
    MASKT(pB0, pB1, NT - 1); partialSM(pB0, pB1, m_reg, mnB, alB); __syncthreads(); RESC(alB);
    finishSM(pB0, pB1, alB, l_reg, pa0, pa1, pa2, pa3); SBAR(); pv_tile<1>(o, vb0, pa0, pa1, pa2, pa3);
    { int t2 = threadIdx.x; asm volatile("" : "+v"(t2)); const int r32e = t2 & 31, hie = (t2 >> 5) & 1;
      float* wse = (float*)(lds + LDS_WS) + wid * 64;
      if (hie == 0) wse[r32e] = l_reg; asm volatile("s_waitcnt lgkmcnt(0)" ::: "memory");
      bf16* Ow = O + (size_t)(P0 + wid * QBLK) * OP + r32e;
#pragma unroll
      for (int r = 0; r < 16; ++r) { const int orow = crow(r, hie); const float rl = __builtin_amdgcn_rcpf(wse[orow]);
#pragma unroll
        for (int d0 = 0; d0 < 4; ++d0) { const float v = o[d0][r] * rl; const float vn = xl_xor1(v);
            if ((r32e & 1) == 0) *(unsigned*)(Ow + (size_t)orow * OP + d0 * 32) = cvtpk(v, vn); } } }
#undef RESC
#undef KBASE
#undef BASE
#undef MASKT
#undef HALF_STEP
#undef ROW
#undef VMW
#undef SLOAD_H
#undef SWRITE_HK
#undef SWRITE_HV
#undef SWRITE_H
}
#undef KSWZ
#undef SBAR
}

namespace hg {
typedef short bf16x8 __attribute__((ext_vector_type(8)));
typedef float f32x4 __attribute__((ext_vector_type(4)));
typedef float f32x2 __attribute__((ext_vector_type(2)));
typedef unsigned u32x4 __attribute__((ext_vector_type(4)));
typedef unsigned u32x2 __attribute__((ext_vector_type(2)));
typedef unsigned short bf16;
#define HLAS __attribute__((address_space(3)))
constexpr int RS = 272, RS64 = 144;
constexpr int O_QT = 0, O_KT = O_QT + 64 * RS, O_KHT = O_KT + 64 * RS, O_IT = O_KHT + 128 * RS64, O_ST = O_IT + 128 * RS64, O_A = O_ST + 128 * RS, O_SEG = O_A + 64 * RS64,
              O_EM = O_SEG + 4096, O_DL = O_EM + 512, O_SSQ = O_DL + 512, O_END = O_SSQ + 2048;
static_assert(O_END <= 131072, "hgrn LDS map");
constexpr int PP = 7168, OP = 2048;
__device__ __forceinline__ float lo(unsigned w) { return __uint_as_float(w << 16); }
__device__ __forceinline__ float hi(unsigned w) { return __uint_as_float(w & 0xffff0000u); }
typedef __bf16 bf16x2_t __attribute__((ext_vector_type(2)));
__device__ __forceinline__ unsigned cvtpk(float a, float b) { const f32x2 v = {a, b}; const bf16x2_t h = __builtin_convertvector(v, bf16x2_t); return __builtin_bit_cast(unsigned, h); }
__device__ __forceinline__ float sigm(float x) { return __builtin_amdgcn_rcpf(1.f + __expf(-x)); }
constexpr int IMG_BYTES = 50176, IMG_KHT = 16384, IMG_IT = 32768, IMG_DL = 49152, OI_BYTES = 16384;
#define HP_LOAD(c_) do { const unsigned short* p_ = (const unsigned short*)Pq + (size_t)((c_) * 64 + 8 * w) * 7168 + 2 * lane; _Pragma("unroll") for (int tt = 0; tt < 8; ++tt) { \
        qw[tt] = *(const unsigned*)(p_ + (size_t)tt * 7168); fw[tt] = *(const unsigned*)(p_ + (size_t)tt * 7168 + 1024); iw[tt] = *(const unsigned*)(p_ + (size_t)tt * 7168 + 2048); } } while (0)
__device__ __forceinline__ void hgrn_produce(const bf16* Pq, const float* lbl, unsigned char* img, unsigned char* oi, HLAS unsigned char* L, int c, int cnext, unsigned (&qw)[8], unsigned (&fw)[8], unsigned (&iw)[8]) {
#define HP_BAR() do { asm volatile("s_waitcnt lgkmcnt(0)" ::: "memory"); __builtin_amdgcn_s_barrier(); asm volatile("" ::: "memory"); } while (0)
    int tid = threadIdx.x; asm volatile("" : "+v"(tid));
    const int w = __builtin_amdgcn_readfirstlane(tid >> 6), lane = tid & 63, fr = lane & 15, fq = lane >> 4;
    const float lb0 = sigm(lbl[2 * lane] - lbl[1024 + 2 * lane]), lb1 = sigm(lbl[2 * lane + 1] - lbl[1024 + 2 * lane + 1]);
    float cs0[8], cs1[8], kf0[8], kf1[8]; float run0 = 0.f, run1 = 0.f;
#pragma unroll
    for (int tt = 0; tt < 8; ++tt) { const float f0 = lb0 + (1.f - lb0) * sigm(lo(fw[tt])), f1 = lb1 + (1.f - lb1) * sigm(hi(fw[tt]));
        run0 += __logf(f0); run1 += __logf(f1); cs0[tt] = run0; cs1[tt] = run1; kf0[tt] = 1.f - f0; kf1[tt] = 1.f - f1; }
    HP_BAR();
    *(HLAS f32x2*)(L + O_SEG + (w * 128 + 2 * lane) * 4) = (f32x2){run0, run1};
    HP_BAR();
    float pre0 = 0.f, pre1 = 0.f, bm0 = 0.f, bm1 = 0.f, bl0 = 0.f, bl1 = 0.f;
#pragma unroll
    for (int ww = 0; ww < 8; ++ww) { const f32x2 sg = *(const HLAS f32x2*)(L + O_SEG + (ww * 128 + 2 * lane) * 4);
        if (ww < w) { pre0 += sg.x; pre1 += sg.y; } if (ww < 4) { bm0 += sg.x; bm1 += sg.y; } bl0 += sg.x; bl1 += sg.y; }
    unsigned kh0[4], kh1[4], it0[4], it1[4];
#pragma unroll
    for (int tt = 0; tt < 8; tt += 2) {
        float h0[2], h1[2];
#pragma unroll
        for (int u = 0; u < 2; ++u) { const int t2 = tt + u; const int t = 8 * w + t2; const float b0 = pre0 + cs0[t2], b1 = pre1 + cs1[t2];
            const float e10 = __expf(b0 - bm0), e11 = __expf(b1 - bm1), e20 = __expf(bm0 - b0), e21 = __expf(bm1 - b1), e30 = __expf(bl0 - b0), e31 = __expf(bl1 - b1);
            const float q0 = lo(qw[t2]), q1 = hi(qw[t2]); const float s0 = q0 * sigm(q0), s1 = q1 * sigm(q1);
            *(HLAS unsigned*)(L + O_QT + t * RS + 4 * lane) = cvtpk(s0 * e10, s1 * e11);
            *(HLAS unsigned*)(L + O_KT + t * RS + 4 * lane) = cvtpk(kf0[t2] * e20, kf1[t2] * e21);
            *(unsigned*)(img + t * 256 + ((((lane >> 2) ^ (t & 15)) << 4) | ((4 * lane) & 15))) = cvtpk(s0 * __expf(b0), s1 * __expf(b1));
            h0[u] = kf0[t2] * e30; h1[u] = kf1[t2] * e31; }
        kh0[tt >> 1] = cvtpk(h0[0], h0[1]); kh1[tt >> 1] = cvtpk(h1[0], h1[1]);
        it0[tt >> 1] = (iw[tt] & 0xffffu) | (iw[tt + 1] << 16); it1[tt >> 1] = (iw[tt] >> 16) | (iw[tt + 1] & 0xffff0000u); }
    *(HLAS u32x4*)(L + O_IT + (2 * lane) * RS64 + 16 * w) = (u32x4){it0[0], it0[1], it0[2], it0[3]};
    *(HLAS u32x4*)(L + O_IT + (2 * lane + 1) * RS64 + 16 * w) = (u32x4){it1[0], it1[1], it1[2], it1[3]};
    { const int sw = (w ^ (lane & 7)) << 4;
      *(u32x4*)(img + IMG_KHT + (2 * lane) * 128 + sw) = (u32x4){kh0[0], kh0[1], kh0[2], kh0[3]};
      *(u32x4*)(img + IMG_KHT + (2 * lane + 1) * 128 + sw) = (u32x4){kh1[0], kh1[1], kh1[2], kh1[3]};
      *(u32x4*)(img + IMG_IT + (2 * lane) * 128 + sw) = (u32x4){it0[0], it0[1], it0[2], it0[3]};
      *(u32x4*)(img + IMG_IT + (2 * lane + 1) * 128 + sw) = (u32x4){it1[0], it1[1], it1[2], it1[3]}; }
    if (w == 0) *(f32x2*)(img + IMG_DL + 8 * lane) = (f32x2){__expf(bl0), __expf(bl1)};
    if (cnext >= 0) HP_LOAD(cnext);
    HP_BAR();
    { const int tt = w >> 1;
#pragma unroll
      for (int si = 0; si < 2; ++si) { const int ss = 2 * (w & 1) + si; u32x2 outw = (u32x2){0u, 0u};
        if (ss <= tt) { f32x4 acc = (f32x4){0.f, 0.f, 0.f, 0.f};
#pragma unroll
            for (int kk = 0; kk < 4; ++kk) { const bf16x8 a = *(const HLAS bf16x8*)(L + O_KT + (16 * ss + fr) * RS + (32 * kk + 8 * fq) * 2), b = *(const HLAS bf16x8*)(L + O_QT + (16 * tt + fr) * RS + (32 * kk + 8 * fq) * 2);
                acc = __builtin_amdgcn_mfma_f32_16x16x32_bf16(a, b, acc, 0, 0, 0); }
#pragma unroll
            for (int r = 0; r < 4; ++r) if (16 * ss + 4 * fq + r > 16 * tt + fr) acc[r] = 0.f;
            outw = (u32x2){cvtpk(acc[0], acc[1]), cvtpk(acc[2], acc[3])}; }
        *(HLAS u32x2*)(L + O_A + (16 * tt + fr) * RS64 + (16 * ss + 4 * fq) * 2) = outw; } }
    HP_BAR();
    bf16x8 itf[2];
#pragma unroll
    for (int kk = 0; kk < 2; ++kk) itf[kk] = *(const HLAS bf16x8*)(L + O_IT + (16 * w + fr) * RS64 + (32 * kk + 8 * fq) * 2);
#pragma unroll
    for (int tt = 0; tt < 4; ++tt) { f32x4 acc = (f32x4){0.f, 0.f, 0.f, 0.f};
#pragma unroll
        for (int kk = 0; kk < 2; ++kk) { const bf16x8 b = *(const HLAS bf16x8*)(L + O_A + (16 * tt + fr) * RS64 + (32 * kk + 8 * fq) * 2); acc = __builtin_amdgcn_mfma_f32_16x16x32_bf16(itf[kk], b, acc, 0, 0, 0); }
        *(u32x2*)(oi + ((tt * 8 + w) * 64 + lane) * 8) = (u32x2){cvtpk(acc[0], acc[1]), cvtpk(acc[2], acc[3])}; }
}
#undef HP_BAR
constexpr int ST_BYTES = 32768;
__device__ __forceinline__ void hgrn_scan(const unsigned char* img0, unsigned char* st0, HLAS unsigned char* L, int nchunk) {
    int tid = threadIdx.x; asm volatile("" : "+v"(tid));
    const int w = __builtin_amdgcn_readfirstlane(tid >> 6), lane = tid & 63, fr = lane & 15, fq = lane >> 4;
    f32x4 Sacc[8];
#pragma unroll
    for (int kt = 0; kt < 8; ++kt) Sacc[kt] = (f32x4){0.f, 0.f, 0.f, 0.f};
#define HS_DMA(c, buf) do { const unsigned char* g_ = img0 + (size_t)(c) * IMG_BYTES + lane * 16; _Pragma("unroll") for (int p_ = 2; p_ < 6; ++p_) \
        __builtin_amdgcn_global_load_lds((const unsigned*)(g_ + (p_ * 8 + w) * 1024), (HLAS unsigned*)(L + (buf) * IMG_BYTES + (p_ * 8 + w) * 1024), 16, 0, 0); \
        if (w == 0) __builtin_amdgcn_global_load_lds((const unsigned*)(g_ + 48 * 1024), (HLAS unsigned*)(L + (buf) * IMG_BYTES + 48 * 1024), 16, 0, 0); } while (0)
    __syncthreads();
    HS_DMA(0, 0);
    asm volatile("s_waitcnt vmcnt(0)" ::: "memory"); __syncthreads();
    for (int c = 0; c < nchunk; ++c) {
        HLAS unsigned char* B = L + (c & 1) * IMG_BYTES;
        if (c + 1 < nchunk) HS_DMA(c + 1, (c + 1) & 1);
        unsigned char* stc = st0 + (size_t)c * ST_BYTES + (16 * w + fr) * 256 + 8 * (fq & 1);
#pragma unroll
        for (int kt = 0; kt < 8; ++kt) *(u32x2*)(stc + (((2 * kt + (fq >> 1)) ^ fr) << 4)) = (u32x2){cvtpk(Sacc[kt][0], Sacc[kt][1]), cvtpk(Sacc[kt][2], Sacc[kt][3])};
        bf16x8 itf[2], kf[8][2]; f32x4 dv[8];
#pragma unroll
        for (int kk = 0; kk < 2; ++kk) itf[kk] = *(const HLAS bf16x8*)(B + IMG_IT + (16 * w + fr) * 128 + (((4 * kk + fq) ^ (fr >> 1)) << 4));
#pragma unroll
        for (int kt = 0; kt < 8; ++kt) { dv[kt] = *(const HLAS f32x4*)(B + IMG_DL + (16 * kt + 4 * fq) * 4);
#pragma unroll
            for (int kk = 0; kk < 2; ++kk) kf[kt][kk] = *(const HLAS bf16x8*)(B + IMG_KHT + (16 * kt + fr) * 128 + (((4 * kk + fq) ^ (fr >> 1)) << 4)); }
#pragma unroll
        for (int kt = 0; kt < 8; ++kt) { f32x4 acc = Sacc[kt] * dv[kt];
#pragma unroll
            for (int kk = 0; kk < 2; ++kk) acc = __builtin_amdgcn_mfma_f32_16x16x32_bf16(kf[kt][kk], itf[kk], acc, 0, 0, 0);
            Sacc[kt] = acc; }
        asm volatile("s_waitcnt vmcnt(8) lgkmcnt(0)" ::: "memory"); __builtin_amdgcn_s_barrier(); asm volatile("" ::: "memory");
    }
#undef HS_DMA
}
constexpr int F_QT = 0, F_ST = 16384, F_SSQ = 49152, F_END = F_SSQ + 2048;
__device__ __forceinline__ void hgrn_finish(const unsigned char* img, const unsigned char* st, const unsigned char* oi, const bf16* Pg  , bf16* Oc  , const float* gnorm, HLAS unsigned char* L) {
    int tid = threadIdx.x; asm volatile("" : "+v"(tid));
    const int w = __builtin_amdgcn_readfirstlane(tid >> 6), lane = tid & 63, fr = lane & 15, fq = lane >> 4;
    const f32x4 gn = *(const f32x4*)(gnorm + 16 * w + 4 * fq);
    __syncthreads();
#pragma unroll
    for (int p_ = 0; p_ < 2; ++p_) __builtin_amdgcn_global_load_lds((const unsigned*)(img + lane * 16 + (p_ * 8 + w) * 1024), (HLAS unsigned*)(L + F_QT + (p_ * 8 + w) * 1024), 16, 0, 0);
#pragma unroll
    for (int p_ = 0; p_ < 4; ++p_) __builtin_amdgcn_global_load_lds((const unsigned*)(st + lane * 16 + (p_ * 8 + w) * 1024), (HLAS unsigned*)(L + F_ST + (p_ * 8 + w) * 1024), 16, 0, 0);
    u32x2 gw[4], ow[4];
#pragma unroll
    for (int tt = 0; tt < 4; ++tt) { gw[tt] = *(const u32x2*)(Pg + (size_t)(16 * tt + fr) * PP + 16 * w + 4 * fq); ow[tt] = *(const u32x2*)(oi + ((tt * 8 + w) * 64 + lane) * 8); }
    asm volatile("s_waitcnt vmcnt(0)" ::: "memory"); __syncthreads();
    bf16x8 stf[4], qf[4][4];
#pragma unroll
    for (int kk = 0; kk < 4; ++kk) stf[kk] = *(const HLAS bf16x8*)(L + F_ST + (16 * w + fr) * 256 + (((4 * kk + fq) ^ fr) << 4));
#pragma unroll
    for (int tt = 0; tt < 4; ++tt)
#pragma unroll
        for (int kk = 0; kk < 4; ++kk) qf[tt][kk] = *(const HLAS bf16x8*)(L + F_QT + (16 * tt + fr) * 256 + (((4 * kk + fq) ^ fr) << 4));
    f32x4 oacc[4];
#pragma unroll
    for (int tt = 0; tt < 4; ++tt) { f32x4 acc = (f32x4){lo(ow[tt].x), hi(ow[tt].x), lo(ow[tt].y), hi(ow[tt].y)};
#pragma unroll
        for (int kk = 0; kk < 4; ++kk) acc = __builtin_amdgcn_mfma_f32_16x16x32_bf16(stf[kk], qf[tt][kk], acc, 0, 0, 0);
        oacc[tt] = acc; float ss = (acc[0] * acc[0] + acc[1] * acc[1]) + (acc[2] * acc[2] + acc[3] * acc[3]);
        ss = xl_add32(xl_add16(ss));
        if (fq == 0) *(HLAS float*)(L + F_SSQ + ((16 * tt + fr) * 8 + w) * 4) = ss; }
    __syncthreads();
#pragma unroll
    for (int tt = 0; tt < 4; ++tt) { const f32x4 s0 = *(const HLAS f32x4*)(L + F_SSQ + (16 * tt + fr) * 32), s1 = *(const HLAS f32x4*)(L + F_SSQ + (16 * tt + fr) * 32 + 16);
        const float tot = ((s0[0] + s0[1]) + (s0[2] + s0[3])) + ((s1[0] + s1[1]) + (s1[2] + s1[3]));
        const float rstd = 1.0f / sqrtf(tot * (1.f / 128.f) + 1e-6f);
        const float g0 = lo(gw[tt].x), g1 = hi(gw[tt].x), g2 = lo(gw[tt].y), g3 = hi(gw[tt].y);
        const float y0 = oacc[tt][0] * rstd * gn[0] * (g0 * sigm(g0)), y1 = oacc[tt][1] * rstd * gn[1] * (g1 * sigm(g1)), y2 = oacc[tt][2] * rstd * gn[2] * (g2 * sigm(g2)), y3 = oacc[tt][3] * rstd * gn[3] * (g3 * sigm(g3));
        *(u32x2*)(Oc + (size_t)(16 * tt + fr) * OP + 16 * w + 4 * fq) = (u32x2){cvtpk(y0, y1), cvtpk(y2, y3)}; }
}
__device__ __forceinline__ void hgrn_finish_run(const unsigned char* img0, const unsigned char* st0, const unsigned char* oi0, const bf16* Pg0  , bf16* Oc0  ,
                                                const float* gnorm, HLAS unsigned char* L, HLAS unsigned char* SSQ, int ch0, int dch, int n) {
    int tid = threadIdx.x; asm volatile("" : "+v"(tid));
    const int w = __builtin_amdgcn_readfirstlane(tid >> 6), lane = tid & 63, fr = lane & 15, fq = lane >> 4;
    const f32x4 gn = *(const f32x4*)(gnorm + 16 * w + 4 * fq);
    __syncthreads();
#define FR_BAR() do { asm volatile("s_waitcnt lgkmcnt(0)" ::: "memory"); __builtin_amdgcn_s_barrier(); asm volatile("" ::: "memory"); } while (0)
#define FR_LOAD(ch_, B_, gw_, ow_) do { const unsigned char* img_ = img0 + (size_t)(ch_) * IMG_BYTES; const unsigned char* st_ = st0 + (size_t)(ch_) * ST_BYTES; const unsigned char* oi_ = oi0 + (size_t)(ch_) * OI_BYTES; \
        const bf16* Pg_ = Pg0 + (size_t)(ch_) * 64 * PP; \
        _Pragma("unroll") for (int p_ = 0; p_ < 2; ++p_) __builtin_amdgcn_global_load_lds((const unsigned*)(img_ + lane * 16 + (p_ * 8 + w) * 1024), (HLAS unsigned*)((B_) + F_QT + (p_ * 8 + w) * 1024), 16, 0, 0); \
        _Pragma("unroll") for (int p_ = 0; p_ < 4; ++p_) __builtin_amdgcn_global_load_lds((const unsigned*)(st_ + lane * 16 + (p_ * 8 + w) * 1024), (HLAS unsigned*)((B_) + F_ST + (p_ * 8 + w) * 1024), 16, 0, 0); \
        _Pragma("unroll") for (int tt = 0; tt < 4; ++tt) { gw_[tt] = *(const u32x2*)(Pg_ + (size_t)(16 * tt + fr) * PP + 16 * w + 4 * fq); ow_[tt] = *(const u32x2*)(oi_ + ((tt * 8 + w) * 64 + lane) * 8); } } while (0)
#define FR_COMP(ch_, B_, gw_, ow_) do { \
        bf16x8 stf[4], qf[4][4]; \
        _Pragma("unroll") for (int kk = 0; kk < 4; ++kk) stf[kk] = *(const HLAS bf16x8*)((B_) + F_ST + (16 * w + fr) * 256 + (((4 * kk + fq) ^ fr) << 4)); \
        _Pragma("unroll") for (int tt = 0; tt < 4; ++tt) _Pragma("unroll") for (int kk = 0; kk < 4; ++kk) qf[tt][kk] = *(const HLAS bf16x8*)((B_) + F_QT + (16 * tt + fr) * 256 + (((4 * kk + fq) ^ fr) << 4)); \
        f32x4 oacc[4]; \
        _Pragma("unroll") for (int tt = 0; tt < 4; ++tt) { f32x4 acc = (f32x4){lo(ow_[tt].x), hi(ow_[tt].x), lo(ow_[tt].y), hi(ow_[tt].y)}; \
            _Pragma("unroll") for (int kk = 0; kk < 4; ++kk) acc = __builtin_amdgcn_mfma_f32_16x16x32_bf16(stf[kk], qf[tt][kk], acc, 0, 0, 0); \
            oacc[tt] = acc; float ss = (acc[0] * acc[0] + acc[1] * acc[1]) + (acc[2] * acc[2] + acc[3] * acc[3]); \
            ss = xl_add32(xl_add16(ss)); \
            if (fq == 0) *(HLAS float*)(SSQ + ((16 * tt + fr) * 8 + w) * 4) = ss; } \
        FR_BAR(); \
        bf16* Oc_ = Oc0 + (size_t)(ch_) * 64 * OP; \
        _Pragma("unroll") for (int tt = 0; tt < 4; ++tt) { const f32x4 s0 = *(const HLAS f32x4*)(SSQ + (16 * tt + fr) * 32), s1 = *(const HLAS f32x4*)(SSQ + (16 * tt + fr) * 32 + 16); \
            const float tot = ((s0[0] + s0[1]) + (s0[2] + s0[3])) + ((s1[0] + s1[1]) + (s1[2] + s1[3])); \
            const float rstd = 1.0f / sqrtf(tot * (1.f / 128.f) + 1e-6f); \
            const float g0 = lo(gw_[tt].x), g1 = hi(gw_[tt].x), g2 = lo(gw_[tt].y), g3 = hi(gw_[tt].y); \
            const float y0 = oacc[tt][0] * rstd * gn[0] * (g0 * sigm(g0)), y1 = oacc[tt][1] * rstd * gn[1] * (g1 * sigm(g1)), y2 = oacc[tt][2] * rstd * gn[2] * (g2 * sigm(g2)), y3 = oacc[tt][3] * rstd * gn[3] * (g3 * sigm(g3)); \
            *(u32x2*)(Oc_ + (size_t)(16 * tt + fr) * OP + 16 * w + 4 * fq) = (u32x2){cvtpk(y0, y1), cvtpk(y2, y3)}; } } while (0)
#define FR_WAIT(k_) do { const int fut_ = (n - 1 - (k_)) < 2 ? (n - 1 - (k_)) : 2; \
        if (fut_ == 2) { if ((k_) > 0) asm volatile("s_waitcnt vmcnt(32)" ::: "memory"); else asm volatile("s_waitcnt vmcnt(28)" ::: "memory"); } \
        else if (fut_ == 1) { if ((k_) > 0) asm volatile("s_waitcnt vmcnt(18)" ::: "memory"); else asm volatile("s_waitcnt vmcnt(14)" ::: "memory"); } \
        else asm volatile("s_waitcnt vmcnt(0)" ::: "memory"); FR_BAR(); } while (0)
    constexpr int FB = 49152;
    HLAS unsigned char* B0 = L; HLAS unsigned char* B1 = L + FB; HLAS unsigned char* B2 = L + 2 * FB;
    u32x2 gA[4], oA[4], gB[4], oB[4], gC[4], oC[4];
    FR_LOAD(ch0, B0, gA, oA);
    if (n > 1) FR_LOAD(ch0 + dch, B1, gB, oB);
    for (int k = 0; k < n; k += 3) {
        const int c0 = ch0 + k * dch;
        if (k + 2 < n) FR_LOAD(c0 + 2 * dch, B2, gC, oC);
        FR_WAIT(k); FR_COMP(c0, B0, gA, oA);
        if (k + 1 >= n) break;
        if (k + 3 < n) FR_LOAD(c0 + 3 * dch, B0, gA, oA);
        FR_WAIT(k + 1); FR_COMP(c0 + dch, B1, gB, oB);
        if (k + 2 >= n) break;
        if (k + 4 < n) FR_LOAD(c0 + 4 * dch, B1, gB, oB);
        FR_WAIT(k + 2); FR_COMP(c0 + 2 * dch, B2, gC, oC);
    }
#undef FR_LOAD
#undef FR_COMP
#undef FR_WAIT
#undef FR_BAR
}
#undef HLAS
}

constexpr int NWAVES = 8;
constexpr int N_LAUNCHES = MK_N_LAUNCHES;
constexpr int PER_PHASE = 9;
constexpr int DM = 2048, NB = 4, SEQ = 2048, M = NB * SEQ, INC = 7168, AW = 1024, HD = 128, NH = 8, NE = 16, DE = 1024;
constexpr int MOBA_BS = 256, MOBA_NB = SEQ / MOBA_BS;
constexpr float RMS_EPS = 1e-6f;
constexpr int SLOT_CAP = 2 * M + NE * 256;

constexpr size_t MiB = 1u << 20;
constexpr size_t WS_CTL = 0, CTL_ZERO_BYTES = 128 * 1024;
constexpr size_t WS_WIN = 2 * MiB;
constexpr size_t WS_WOUT = 30 * MiB;
constexpr size_t WS_WGU = 38 * MiB;
constexpr size_t WS_WD = 166 * MiB;
constexpr size_t WS_XN = 230 * MiB;
constexpr size_t WS_PROJ = 262 * MiB;
constexpr size_t WS_CAT = 374 * MiB;
constexpr size_t WS_X1 = 406 * MiB;
constexpr size_t WS_MISC = 470 * MiB;
constexpr size_t WS_END = 472 * MiB;
constexpr size_t WS_HIMG = WS_X1;
constexpr size_t WS_HST = 472 * MiB;
constexpr size_t WS_HOI = WS_XN;
constexpr size_t WS_HID = 342 * MiB;
constexpr size_t WS_Y = 262 * MiB;
static_assert(WS_HID + (size_t)SLOT_CAP * DE <= WS_X1 && WS_Y + (size_t)2 * M * DM * 2 <= WS_HID, "overlay map");
constexpr size_t MS_WRT = 0;
constexpr size_t MS_ROWL = 512 * 1024;
constexpr size_t MS_WL = 1024 * 1024;
constexpr int CW_TMO = 0, CW_CODE = 1;
constexpr int CW_BAR = 4096;
constexpr int CW_HFLAG = 20480;
constexpr int CW_CNT = 16384;

constexpr int RING_OFF = 0, RING_BYTES = 147456;
constexpr int LDSCTL_OFF = RING_BYTES, MISC_OFF = LDSCTL_OFF + 320;
constexpr int FIN_SSQ_OFF = 149504;
constexpr int WLL_OFF = 149504 + 2048;
constexpr int LDS_BYTES = 149504 + 2048 + 8192;

#define GAS __attribute__((address_space(1)))
#define LAS __attribute__((address_space(3)))
typedef unsigned short bf16;
typedef unsigned v4u __attribute__((ext_vector_type(4)));
typedef unsigned v2u __attribute__((ext_vector_type(2)));
typedef float f32x4 __attribute__((ext_vector_type(4)));
typedef float f32x2 __attribute__((ext_vector_type(2)));
typedef int i32x4 __attribute__((ext_vector_type(4)));
typedef GAS unsigned gu32;
#define RLX_AGENT __ATOMIC_RELAXED, __HIP_MEMORY_SCOPE_AGENT
#define LDS_WAIT() asm volatile("s_waitcnt lgkmcnt(0)" ::: "memory")
#define VM_WAIT() asm volatile("s_waitcnt vmcnt(0)" ::: "memory")
__device__ __forceinline__ unsigned f2bf(float f) { unsigned u = __builtin_bit_cast(unsigned, f); return (u + 0x7fffu + ((u >> 16) & 1u)) >> 16; }
__device__ __forceinline__ unsigned pk2(float lo, float hi) { return f2bf(lo) | (f2bf(hi) << 16); }
__device__ __forceinline__ float bf_lo(unsigned w) { return __uint_as_float(w << 16); }
__device__ __forceinline__ float bf_hi(unsigned w) { return __uint_as_float(w & 0xffff0000u); }
__device__ __forceinline__ float bf1(bf16 h) { return __uint_as_float((unsigned)h << 16); }

#define XB_TMO      128
#define XB_XCNT(j)  (256  + 64 * (j))
#define XB_XSUB(j)  (1280 + 64 * (j))
#define XB_XGEN(j)  (2304 + 64 * (j))
#define XB_TOP      3328
#define XB_TOPGEN   3392
#define XCD_BAR_WORDS 3456
#define XB_SPIN_CAP (1u << 18)
__device__ __forceinline__ unsigned xb_ld(unsigned* p)              { return __hip_atomic_load(p, __ATOMIC_RELAXED, __HIP_MEMORY_SCOPE_AGENT); }
__device__ __forceinline__ unsigned xb_add(unsigned* p, unsigned v) { return __hip_atomic_fetch_add(p, v, __ATOMIC_RELAXED, __HIP_MEMORY_SCOPE_AGENT); }
__device__ __forceinline__ unsigned xb_xcc_id() { return (unsigned)__builtin_amdgcn_s_getreg((3 << 11) | 20) & 0xFu; }
#define XB_SPIN(cond, bar) do { unsigned _sp = 0; while (cond) { __builtin_amdgcn_s_sleep(1); \
    if ((++_sp & 255u) == 0u) { if (xb_ld(&(bar)[XB_TMO])) break; if (_sp > XB_SPIN_CAP) { atomicAdd(&(bar)[XB_TMO], 1u); break; } } } } while (0)
struct XcdBarrier { unsigned* bar; unsigned x; volatile LAS unsigned* st; };
__device__ __forceinline__ XcdBarrier xcd_barrier_post(unsigned* bar, volatile LAS unsigned* st) {
    XcdBarrier b; b.bar = bar; b.x = xb_xcc_id(); b.st = st;
    if (threadIdx.x == 0) st[3] = xb_add(&bar[XB_XCNT(b.x)], 1u);
    return b;
}
__device__ __forceinline__ void xcd_barrier_complete(unsigned* bar, unsigned x, unsigned& nloc, unsigned& nx, unsigned& ev) {
    const unsigned G = gridDim.x * gridDim.y * gridDim.z;
    unsigned sum, cnt, mine, sp = 0u;
    for (;;) {
        sum = 0u; cnt = 0u; mine = 0u; ev = 1u;
#pragma unroll
        for (unsigned j = 0; j < 16; ++j) { const unsigned c = xb_ld(&bar[XB_XCNT(j)]); sum += c; cnt += (c > 0u) ? 1u : 0u; mine = (j == x) ? c : mine; if (c != ((j < 8u) ? G / 8u : 0u)) ev = 0u; }
        if (sum == G) break;
        __builtin_amdgcn_s_sleep(1);
        if ((++sp & 255u) == 0u) { if (xb_ld(&bar[XB_TMO])) break; if (sp > XB_SPIN_CAP) { atomicAdd(&bar[XB_TMO], 1u); break; } }
    }
    nloc = mine > 0u ? mine : 1u; nx = cnt > 0u ? cnt : 1u;
}
__device__ __forceinline__ void xcd_barrier(const XcdBarrier& b) {
    asm volatile("s_waitcnt vmcnt(0)" ::: "memory");
    __syncthreads();
    if (threadIdx.x == 0) {
        unsigned* bar = b.bar;
        __builtin_amdgcn_s_waitcnt(0);
        unsigned nloc = b.st[0], nx = b.st[1];
        if (nloc == 0u) { unsigned ev; xcd_barrier_complete(bar, b.x, nloc, nx, ev); b.st[0] = nloc; b.st[1] = nx; b.st[2] = ev; }
        const unsigned old = xb_add(&bar[XB_XSUB(b.x)], 1u);
        const unsigned gen = old / nloc;
        if (old + 1u == (gen + 1u) * nloc) {
            __builtin_amdgcn_fence(__ATOMIC_RELEASE, "agent");
            asm volatile("s_waitcnt vmcnt(0)" ::: "memory");
            const unsigned og = xb_add(&bar[XB_TOP], 1u);
            const unsigned tg = og / nx;
            if (og + 1u == (tg + 1u) * nx) xb_add(&bar[XB_TOPGEN], 1u);
            else XB_SPIN(xb_ld(&bar[XB_TOPGEN]) == tg, bar);
            __builtin_amdgcn_fence(__ATOMIC_ACQUIRE, "agent");
            xb_add(&bar[XB_XGEN(b.x)], 1u);
            asm volatile("s_waitcnt vmcnt(0)" ::: "memory");
        } else {
            XB_SPIN(xb_ld(&bar[XB_XGEN(b.x)]) == gen, bar);
            __builtin_amdgcn_fence(__ATOMIC_ACQUIRE, "agent");
            asm volatile("s_waitcnt vmcnt(0)" ::: "memory");
        }
    }
    __syncthreads();
}

struct Args { const float* in[15]; float* out; unsigned char* ws; int ph_lo, ph_hi, li, pad; };

#define XB_LSUB(j)  (4096 + 64 * (j))
__device__ __forceinline__ void xcd_local_barrier(const XcdBarrier& b, const int slot = 0, const bool wait = true, const unsigned target = 0u) {
    asm volatile("s_waitcnt vmcnt(0)" ::: "memory");
    __syncthreads();
    if (threadIdx.x == 0) {
        unsigned* bar = b.bar;
        const unsigned nloc = target ? target : b.st[0];
        __builtin_amdgcn_fence(__ATOMIC_RELEASE, "workgroup");
        (void)xb_add(&bar[XB_LSUB(b.x) + 1024 * slot], 1u);
        if (wait) {
            XB_SPIN(xb_ld(&bar[XB_LSUB(b.x) + 1024 * slot]) < nloc, bar);
            __builtin_amdgcn_fence(__ATOMIC_ACQUIRE, "agent");
            asm volatile("s_waitcnt vmcnt(0)" ::: "memory");
        }
    }
    __syncthreads();
}
struct Frame {
    LAS unsigned char* lds;
    volatile LAS unsigned* MISC;
    gu32* ctl;
    int tid, lane, wave;
    int vcu, G;
    const float* x; float* out;
    const float *g_mix, *w_in, *lb_logits, *g_onorm, *w_out, *g_ffn, *w_grp, *b_grp, *w_er, *b_er, *w_gate, *w_up, *w_down, *g_fin;
    bf16 *WIN, *WOUT, *WGU, *WD, *XN, *PROJ, *CAT, *HID, *Y;
    float* X1; float* WRT; int* ROWL; float* WL;
};
__device__ __forceinline__ void set_ptrs(Frame& F) {
    const __attribute__((address_space(4))) Args* ap = (const __attribute__((address_space(4))) Args*)__builtin_amdgcn_kernarg_segment_ptr();
    asm volatile("" : "+s"(ap));
    unsigned char* ws = ap->ws;
    F.ctl = (gu32*)(ws + WS_CTL);
    F.x = ap->in[0]; F.g_mix = ap->in[1]; F.w_in = ap->in[2]; F.lb_logits = ap->in[3]; F.g_onorm = ap->in[4]; F.w_out = ap->in[5]; F.g_ffn = ap->in[6];
    F.w_grp = ap->in[7]; F.b_grp = ap->in[8]; F.w_er = ap->in[9]; F.b_er = ap->in[10]; F.w_gate = ap->in[11]; F.w_up = ap->in[12]; F.w_down = ap->in[13]; F.g_fin = ap->in[14];
    F.out = ap->out;
    F.WIN = (bf16*)(ws + WS_WIN); F.WOUT = (bf16*)(ws + WS_WOUT); F.WGU = (bf16*)(ws + WS_WGU); F.WD = (bf16*)(ws + WS_WD);
    F.XN = (bf16*)(ws + WS_XN); F.PROJ = (bf16*)(ws + WS_PROJ); F.CAT = (bf16*)(ws + WS_CAT); F.X1 = (float*)(ws + WS_X1);
    F.HID = (bf16*)(ws + WS_HID); F.Y = (bf16*)(ws + WS_Y);
    F.WRT = (float*)(ws + WS_MISC + MS_WRT); F.ROWL = (int*)(ws + WS_MISC + MS_ROWL); F.WL = (float*)(ws + WS_MISC + MS_WL);
}
__device__ __forceinline__ float wave_sum(float v) { return xl_wave_sum(v); }
template <bool FP8>
__device__ __forceinline__ void xpose_item(const float* W, int N, void* WT, int Kd, int k0, int n0, int drow0, LAS float* scr, int lane, float mul) {
    { const int kq = lane >> 4, c4 = lane & 15;
#pragma unroll
      for (int i = 0; i < 16; ++i) { const int kk = 4 * i + kq; const f32x4 v = *(const GAS f32x4*)(W + (size_t)(k0 + kk) * N + n0 + 4 * c4);
          *(LAS f32x4*)(scr + kk * 64 + 4 * (c4 ^ ((kk >> 3) & 7))) = v; } }
    LDS_WAIT(); asm volatile("" ::: "memory");
    if constexpr (!FP8) { const int c = lane & 7;
#pragma unroll
        for (int j = 0; j < 8; ++j) { const int n = (lane >> 3) + 8 * j; const LAS float* sp = scr + (8 * c) * 64 + (n ^ (c << 2));
            v4u o; o.x = pk2(sp[0 * 64], sp[1 * 64]); o.y = pk2(sp[2 * 64], sp[3 * 64]); o.z = pk2(sp[4 * 64], sp[5 * 64]); o.w = pk2(sp[6 * 64], sp[7 * 64]);
            *(GAS v4u*)((bf16*)WT + (size_t)(drow0 + n) * Kd + k0 + 8 * c) = o; } }
    else { const int c = lane & 3;
#pragma unroll
        for (int j = 0; j < 4; ++j) { const int n = (lane >> 2) + 16 * j; const LAS float* s0 = scr + (16 * c) * 64 + (n ^ ((2 * c) << 2)); const LAS float* s1 = scr + (16 * c + 8) * 64 + (n ^ ((2 * c + 1) << 2));
            v4u o;
            o.x = pg8::pk4_fp8(s0[0 * 64] * mul, s0[1 * 64] * mul, s0[2 * 64] * mul, s0[3 * 64] * mul); o.y = pg8::pk4_fp8(s0[4 * 64] * mul, s0[5 * 64] * mul, s0[6 * 64] * mul, s0[7 * 64] * mul);
            o.z = pg8::pk4_fp8(s1[0 * 64] * mul, s1[1 * 64] * mul, s1[2 * 64] * mul, s1[3 * 64] * mul); o.w = pg8::pk4_fp8(s1[4 * 64] * mul, s1[5 * 64] * mul, s1[6 * 64] * mul, s1[7 * 64] * mul);
            *(GAS v4u*)((unsigned char*)WT + (size_t)(drow0 + n) * Kd + k0 + 16 * c) = o; } }
    LDS_WAIT(); asm volatile("" ::: "memory");
}
struct XpItem { const float* src; int N; void* dst; int Kd; int fp8; float mul; };
__device__ __forceinline__ void xp_load(const XpItem& it, int lane, f32x4 (&v)[16]) {
    const int kq = lane >> 4, c4 = lane & 15;
#pragma unroll
    for (int i = 0; i < 16; ++i) v[i] = *(const GAS f32x4*)(it.src + (size_t)(4 * i + kq) * it.N + 4 * c4);
}
__device__ __forceinline__ void xp_store(const XpItem& it, int lane, const f32x4 (&v)[16], LAS float* scr) {
    { const int kq = lane >> 4, c4 = lane & 15;
#pragma unroll
      for (int i = 0; i < 16; ++i) { const int kk = 4 * i + kq; *(LAS f32x4*)(scr + kk * 64 + 4 * (c4 ^ ((kk >> 3) & 7))) = v[i]; } }
    LDS_WAIT(); asm volatile("" ::: "memory");
    if (!it.fp8) { const int c = lane & 7;
#pragma unroll
        for (int j = 0; j < 8; ++j) { const int n = (lane >> 3) + 8 * j; const LAS float* sp = scr + (8 * c) * 64 + (n ^ (c << 2));
            v4u o; o.x = pk2(sp[0 * 64], sp[1 * 64]); o.y = pk2(sp[2 * 64], sp[3 * 64]); o.z = pk2(sp[4 * 64], sp[5 * 64]); o.w = pk2(sp[6 * 64], sp[7 * 64]);
            *(GAS v4u*)((bf16*)it.dst + (size_t)n * it.Kd + 8 * c) = o; } }
    else { const int c = lane & 3; const float mul = it.mul;
#pragma unroll
        for (int j = 0; j < 4; ++j) { const int n = (lane >> 2) + 16 * j; const LAS float* s0 = scr + (16 * c) * 64 + (n ^ ((2 * c) << 2)); const LAS float* s1 = scr + (16 * c + 8) * 64 + (n ^ ((2 * c + 1) << 2));
            v4u o;
            o.x = pg8::pk4_fp8(s0[0 * 64] * mul, s0[1 * 64] * mul, s0[2 * 64] * mul, s0[3 * 64] * mul); o.y = pg8::pk4_fp8(s0[4 * 64] * mul, s0[5 * 64] * mul, s0[6 * 64] * mul, s0[7 * 64] * mul);
            o.z = pg8::pk4_fp8(s1[0 * 64] * mul, s1[1 * 64] * mul, s1[2 * 64] * mul, s1[3 * 64] * mul); o.w = pg8::pk4_fp8(s1[4 * 64] * mul, s1[5 * 64] * mul, s1[6 * 64] * mul, s1[7 * 64] * mul);
            *(GAS v4u*)((unsigned char*)it.dst + (size_t)n * it.Kd + 16 * c) = o; } }
    LDS_WAIT(); asm volatile("" ::: "memory");
}
__device__ __forceinline__ void rms_row_to_bf16(int lane, const float* xrow, const float* g, bf16* orow) {
    const GAS f32x4* xr = (const GAS f32x4*)xrow + lane; const GAS f32x4* gr = (const GAS f32x4*)g + lane;
    f32x4 v[8], gg[8]; float s = 0.f;
#pragma unroll
    for (int j = 0; j < 8; ++j) v[j] = xr[64 * j];
#pragma unroll
    for (int j = 0; j < 8; ++j) gg[j] = gr[64 * j];
    __builtin_amdgcn_sched_barrier(0);
#pragma unroll
    for (int j = 0; j < 8; ++j) s += (v[j].x * v[j].x + v[j].y * v[j].y) + (v[j].z * v[j].z + v[j].w * v[j].w);
    const float rstd = 1.0f / sqrtf(wave_sum(s) * (1.f / DM) + RMS_EPS);
    GAS v2u* o8 = (GAS v2u*)orow + lane;
#pragma unroll
    for (int j = 0; j < 8; ++j) { v2u o; o.x = pk2(v[j].x * rstd * gg[j].x, v[j].y * rstd * gg[j].y); o.y = pk2(v[j].z * rstd * gg[j].z, v[j].w * rstd * gg[j].w); o8[64 * j] = o; }
}

constexpr int I_IN = (DM / 64) * (INC / 64), I_OUT = (DM / 64) * (DM / 64), I_G = NE * (DM / 64) * (DE / 64), I_D = NE * (DE / 64) * (DM / 64);
constexpr int I_MOE = 2 * I_G + I_D;
constexpr int HID_P1 = 8, N_HID_P1 = 128 * 8 * HID_P1;
#ifndef P3_CVT_LIST
#define P3_CVT_LIST 2, 1, 2, 5, 7, 0, 2, 2
#endif
constexpr unsigned long long pack8(int a0, int a1, int a2, int a3, int a4, int a5, int a6, int a7, bool prefix) {
    const int a[8] = {a0, a1, a2, a3, a4, a5, a6, a7}; unsigned long long r = 0; int acc = 0;
    for (int i = 0; i < 8; ++i) { r |= (unsigned long long)(prefix ? acc : a[i]) << (8 * i); acc += a[i]; }
    return r;
}
constexpr int sum8(int a0, int a1, int a2, int a3, int a4, int a5, int a6, int a7) { return a0 + a1 + a2 + a3 + a4 + a5 + a6 + a7; }
constexpr unsigned long long P3_CVT = pack8(P3_CVT_LIST, false), P3_CVT_PRE = pack8(P3_CVT_LIST, true);
constexpr int N_HID_P3 = 256 * sum8(P3_CVT_LIST);
constexpr int N_HID = N_HID_P1 + N_HID_P3;
constexpr int N_HID_P7 = 8192;
static_assert(N_HID + N_HID_P7 <= I_MOE && N_HID_P7 <= I_D, "hidden conversion items");
__device__ __forceinline__ void moe_item(Frame& F, int r, LAS float* scr, int lane) {
    if (r < 2 * I_G) { const int up = r >= I_G; if (up) r -= I_G; constexpr int per = (DM / 64) * (DE / 64); const int e = r / per, q = r % per, nblk = DE / 64, kb = q / nblk, nb = q % nblk, n0 = 64 * nb;
        const int drow = (n0 >> 7) * 256 + (n0 & 127) + up * 128;
        xpose_item<true>((up ? F.w_up : F.w_gate) + (size_t)e * DM * DE, DE, (unsigned char*)F.WGU + (size_t)e * 2048 * DM, DM, 64 * kb, n0, drow, scr, lane, 64.f); return; }
    r -= 2 * I_G;
    { constexpr int per = (DE / 64) * (DM / 64); const int e = r / per, q = r % per, nblk = DM / 64, kb = q / nblk, nb = q % nblk;
        xpose_item<true>(F.w_down + (size_t)e * DE * DM, DM, (unsigned char*)F.WD + (size_t)e * DM * DE, DE, 64 * kb, 64 * nb, 64 * nb, scr, lane, 32.f); }
}
__device__ __forceinline__ XpItem moe_desc(Frame& F, int r) {
    if (r < 2 * I_G) { const int up = r >= I_G; if (up) r -= I_G; constexpr int per = (DM / 64) * (DE / 64); const int e = r / per, q = r % per, nblk = DE / 64, kb = q / nblk, nb = q % nblk, n0 = 64 * nb;
        const int drow = (n0 >> 7) * 256 + (n0 & 127) + up * 128;
        return XpItem{(up ? F.w_up : F.w_gate) + (size_t)e * DM * DE + (size_t)(64 * kb) * DE + n0, DE, (unsigned char*)F.WGU + (size_t)e * 2048 * DM + (size_t)drow * DM + 64 * kb, DM, 1, 64.f}; }
    r -= 2 * I_G;
    { constexpr int per = (DE / 64) * (DM / 64); const int e = r / per, q = r % per, nblk = DM / 64, kb = q / nblk, nb = q % nblk;
        return XpItem{F.w_down + (size_t)e * DE * DM + (size_t)(64 * kb) * DM + 64 * nb, DM, (unsigned char*)F.WD + (size_t)e * DM * DE + (size_t)(64 * nb) * DE + 64 * kb, DE, 1, 32.f}; }
}
__device__ __forceinline__ void moe_items_wave(Frame& F, int first, int cnt) {
    LAS float* scr = (LAS float*)(F.lds + RING_OFF + F.wave * 16384);
    if (cnt <= 0) return;
    f32x4 va[16], vb[16];
    XpItem A = moe_desc(F, first), B = A;
    xp_load(A, F.lane, va);
    for (int i = 0; i < cnt; i += 2) {
        if (i + 1 < cnt) { B = moe_desc(F, first + i + 1); xp_load(B, F.lane, vb); }
        xp_store(A, F.lane, va, scr);
        if (i + 1 >= cnt) break;
        if (i + 2 < cnt) { A = moe_desc(F, first + i + 2); xp_load(A, F.lane, va); }
        xp_store(B, F.lane, vb, scr);
    }
}
__device__ __forceinline__ void p0_prologue(Frame& F) {
    LAS float* scr = (LAS float*)(F.lds + RING_OFF + F.wave * 16384);
    const int gw = F.vcu * NWAVES + F.wave, NGW = F.G * NWAVES;
    const int moe0 = (F.G == 256) ? N_HID : 0;
    const int NITEMS = I_IN + I_OUT + (I_MOE - moe0 - ((F.G == 256) ? N_HID_P7 : 0));
    for (int it = gw; it < NITEMS; it += NGW) {
        int r = it;
        if (r < I_IN) { const int nblk = INC / 64, kb = r / nblk, nb = r % nblk; xpose_item<false>(F.w_in, INC, F.WIN, DM, 64 * kb, 64 * nb, 64 * nb, scr, F.lane, 1.f); continue; } r -= I_IN;
        if (r < I_OUT) { const int nblk = DM / 64, kb = r / nblk, nb = r % nblk; xpose_item<false>(F.w_out, DM, F.WOUT, DM, 64 * kb, 64 * nb, 64 * nb, scr, F.lane, 1.f); continue; } r -= I_OUT;
        moe_item(F, moe0 + r, scr, F.lane);
    }
#define P0_ROW(m_) do { const int m = (m_); rms_row_to_bf16(F.lane, F.x + (size_t)m * DM, F.g_mix, F.XN + (size_t)m * DM); } while (0)
    if (F.G == 256 && NITEMS == 7424) {
        static_assert(M == 8192, "row dealing");
        if (gw >= 1280) { const int w = gw - 1280; for (int k = 0; k < 5; ++k) P0_ROW(w + 768 * k); if ((w & 3) == 0) P0_ROW(7680 + (w >> 2)); }
        else { for (int k = 0; k < 3; ++k) P0_ROW(3840 + gw + 1280 * k); if ((gw & 3) == 0) P0_ROW(7680 + 192 + (gw >> 2)); }
    } else for (int m = gw; m < M; m += NGW) P0_ROW(m);
#undef P0_ROW
    for (int i = gw * 64 + F.lane; i < 20 * DM; i += NGW * 64) { const int c = i / DM, d = i % DM;
        const float w = c < 4 ? F.w_grp[d * 4 + c] : F.w_er[(size_t)((c - 4) >> 2) * DM * 4 + d * 4 + ((c - 4) & 3)];
        F.WRT[i] = w * F.g_ffn[d]; }
}

__device__ __forceinline__ void attn_item_mfma(Frame& F, char* lds, int item) {
    const int qb = 7 - (item >> 5), h = item & 7, b = (item >> 3) & 3;
    const bf16* Pb = F.PROJ + (size_t)b * SEQ * INC + h * HD;
    const float beta = exp2f(-(float)(h + 1)) * 11.313708498984761f;
    moba::moba_unit_ring(Pb, Pb + AW, Pb + 2 * AW, F.CAT + (size_t)b * SEQ * DM + h * HD, qb, beta, lds);
}
template <bool DRY> __device__ __forceinline__ void p4_router(Frame& F) {
    constexpr int NR = 4;
    LAS unsigned char* L = F.lds + RING_OFF;
    LAS unsigned* lcnt = (LAS unsigned*)(L + 131072);
    for (int mbW = F.vcu * (NWAVES * NR); mbW < M; mbW += F.G * (NWAVES * NR)) {
        int lane = F.lane; asm volatile("" : "+v"(lane));
        const int mb = mbW + F.wave * NR;
        if (F.tid < 32) lcnt[F.tid] = 0u;
        v4u xw[NR][4];
#pragma unroll
        for (int r = 0; r < NR; ++r) { const GAS v4u* xr = (const GAS v4u*)((const bf16*)F.X1 + (size_t)(mb + r) * DM) + lane;
#pragma unroll
            for (int j = 0; j < 4; ++j) xw[r][j] = xr[64 * j]; }
        { const float* wsrc = F.WRT + 8 * lane;
#pragma unroll
          for (int i = 0; i < 4; ++i) { const int q = F.wave * 4 + i, c = q >> 3, j = (q >> 1) & 3, h = q & 1;
              __builtin_amdgcn_global_load_lds((const unsigned*)(wsrc + (size_t)c * DM + 512 * j + 4 * h), (LAS unsigned*)(L + q * 1024), 16, 0, 0); }
#pragma unroll
          for (int i = 0; i < 8; ++i) { const int q = F.wave * 8 + i, e = q >> 2, j = (q >> 1) & 1, h = q & 1;
              __builtin_amdgcn_global_load_lds((const unsigned*)(wsrc + (size_t)(4 + e) * DM + 512 * j + 4 * h), (LAS unsigned*)(L + 65536 + q * 1024), 16, 0, 0); } }
        f32x4 v[NR][8]; float rstd[NR];
#pragma unroll
        for (int r = 0; r < NR; ++r) {
#pragma unroll
            for (int j = 0; j < 4; ++j) { const v4u w = xw[r][j]; v[r][2 * j] = (f32x4){bf_lo(w.x), bf_hi(w.x), bf_lo(w.y), bf_hi(w.y)}; v[r][2 * j + 1] = (f32x4){bf_lo(w.z), bf_hi(w.z), bf_lo(w.w), bf_hi(w.w)}; } }
#pragma unroll
        for (int r = 0; r < NR; ++r) { float s = 0.f;
#pragma unroll
            for (int j = 0; j < 8; ++j) s += (v[r][j].x * v[r][j].x + v[r][j].y * v[r][j].y) + (v[r][j].z * v[r][j].z + v[r][j].w * v[r][j].w);
            rstd[r] = 1.0f / sqrtf(wave_sum(s) * (1.f / DM) + RMS_EPS); }
        { const GAS f32x4* gr = (const GAS f32x4*)F.g_ffn + 2 * lane;
#pragma unroll
          for (int j = 0; j < 4; ++j) { const f32x4 g0 = gr[128 * j], g1 = gr[128 * j + 1];
#pragma unroll
            for (int r = 0; r < NR; ++r) { GAS v2u* o8 = (GAS v2u*)((unsigned char*)F.XN + (size_t)(mb + r) * DM) + lane; const float rs = rstd[r];
                v2u o; o.x = pg8::pk4_fp8(v[r][2 * j].x * rs * g0.x, v[r][2 * j].y * rs * g0.y, v[r][2 * j].z * rs * g0.z, v[r][2 * j].w * rs * g0.w);
                o.y = pg8::pk4_fp8(v[r][2 * j + 1].x * rs * g1.x, v[r][2 * j + 1].y * rs * g1.y, v[r][2 * j + 1].z * rs * g1.z, v[r][2 * j + 1].w * rs * g1.w); o8[64 * j] = o; } } }
        asm volatile("s_waitcnt vmcnt(0)" ::: "memory"); __syncthreads();
        const LAS unsigned char* Ll = L + 16 * lane;
        float gl[NR][4];
#pragma unroll
        for (int c = 0; c < 4; ++c) { float a[NR];
#pragma unroll
            for (int r = 0; r < NR; ++r) a[r] = 0.f;
#pragma unroll
            for (int j = 0; j < 8; ++j) { const f32x4 w = *(const LAS f32x4*)(Ll + c * 8192 + j * 1024);
#pragma unroll
                for (int r = 0; r < NR; ++r) a[r] += (v[r][j].x * w.x + v[r][j].y * w.y) + (v[r][j].z * w.z + v[r][j].w * w.w); }
            const float bg = F.b_grp[c];
#pragma unroll
            for (int r = 0; r < NR; ++r) gl[r][c] = wave_sum(a[r]) * rstd[r] + bg; }
        LDS_WAIT(); __syncthreads();
        { const float* wsrc = F.WRT + 8 * lane;
#pragma unroll
          for (int i = 0; i < 8; ++i) { const int q = F.wave * 8 + i, e = q >> 2, j = 2 + ((q >> 1) & 1), h = q & 1;
              __builtin_amdgcn_global_load_lds((const unsigned*)(wsrc + (size_t)(4 + e) * DM + 512 * j + 4 * h), (LAS unsigned*)(L + q * 1024), 16, 0, 0); } }
        int g[NR]; float grp_w[NR];
#pragma unroll
        for (int r = 0; r < NR; ++r) { int gi = 0; float gmax = -INFINITY;
#pragma unroll
            for (int c = 0; c < 4; ++c) { if (gl[r][c] > gmax) { gmax = gl[r][c]; gi = c; } }
            float gs = 0.f;
#pragma unroll
            for (int c = 0; c < 4; ++c) gs += __expf(gl[r][c] - gmax);
            grp_w[r] = 1.f / gs; g[r] = __builtin_amdgcn_readfirstlane(gi); }
        float el[NR][4];
#pragma unroll
        for (int r = 0; r < NR; ++r)
#pragma unroll
            for (int e = 0; e < 4; ++e) { const LAS unsigned char* wr_ = Ll + 65536 + (4 * g[r] + e) * 4096; float a = 0.f;
#pragma unroll
                for (int j = 0; j < 4; ++j) { const f32x4 w = *(const LAS f32x4*)(wr_ + j * 1024); a += (v[r][j].x * w.x + v[r][j].y * w.y) + (v[r][j].z * w.z + v[r][j].w * w.w); }
                el[r][e] = a; }
        asm volatile("s_waitcnt vmcnt(0)" ::: "memory"); __syncthreads();
#pragma unroll
        for (int r = 0; r < NR; ++r)
#pragma unroll
            for (int e = 0; e < 4; ++e) { const LAS unsigned char* wr_ = Ll + (4 * g[r] + e) * 4096; float a = el[r][e];
#pragma unroll
                for (int j = 0; j < 4; ++j) { const f32x4 w = *(const LAS f32x4*)(wr_ + j * 1024); a += (v[r][4 + j].x * w.x + v[r][4 + j].y * w.y) + (v[r][4 + j].z * w.z + v[r][4 + j].w * w.w); }
                el[r][e] = wave_sum(a) * rstd[r] + F.b_er[g[r] * 4 + e]; }
        int e0[NR], e1[NR]; float w0[NR], w1[NR];
#pragma unroll
        for (int r = 0; r < NR; ++r) { int i0 = 0; float m0 = -INFINITY;
#pragma unroll
            for (int e = 0; e < 4; ++e) if (el[r][e] > m0) { m0 = el[r][e]; i0 = e; }
            int i1 = 0; float m1 = -INFINITY;
#pragma unroll
            for (int e = 0; e < 4; ++e) if (e != i0 && el[r][e] > m1) { m1 = el[r][e]; i1 = e; }
            const float p1 = __expf(m1 - m0); w0[r] = grp_w[r] / (1.f + p1); w1[r] = grp_w[r] * p1 / (1.f + p1); e0[r] = g[r] * 4 + i0; e1[r] = g[r] * 4 + i1; }
        int p0[NR], p1_[NR];
        if (lane == 0) {
#pragma unroll
            for (int r = 0; r < NR; ++r) { p0[r] = (int)__hip_atomic_fetch_add((LAS unsigned*)(lcnt + e0[r]), 1u, __ATOMIC_RELAXED, __HIP_MEMORY_SCOPE_WORKGROUP); p1_[r] = (int)__hip_atomic_fetch_add((LAS unsigned*)(lcnt + e1[r]), 1u, __ATOMIC_RELAXED, __HIP_MEMORY_SCOPE_WORKGROUP); } }
        LDS_WAIT(); __syncthreads();
        if (F.tid < NE) { const unsigned n = lcnt[F.tid]; lcnt[16 + F.tid] = n ? __hip_atomic_fetch_add((unsigned*)(F.ctl + CW_CNT + 64 * F.tid), n, RLX_AGENT) : 0u; }
        __syncthreads();
        if (lane == 0) {
#pragma unroll
            for (int r = 0; r < NR; ++r) { const int m = mb + r, q0 = e0[r] * 8192 + (int)lcnt[16 + e0[r]] + p0[r], q1 = e1[r] * 8192 + (int)lcnt[16 + e1[r]] + p1_[r];
                F.ROWL[q0] = m; F.ROWL[q1] = m | (1 << 16); F.WL[q0] = w0[r]; F.WL[q1] = w1[r]; } }
        __syncthreads();
    }
}
__device__ __forceinline__ void load_prefix(Frame& F, LAS int* pre) {
    if (F.tid < NE) pre[32 + F.tid] = (int)__hip_atomic_load((unsigned*)(F.ctl + CW_CNT + 64 * F.tid), RLX_AGENT);
    __syncthreads();
    if (F.tid == 0) { int a = 0;
        for (int e = 0; e < NE; ++e) { pre[e] = a; a += (pre[32 + e] + 255) >> 8; }
        pre[NE] = a; }
    __syncthreads();
}
__device__ __forceinline__ void p7_final(Frame& F) {
    const int gw = F.vcu * NWAVES + F.wave, NGW = F.G * NWAVES, lane = F.lane;
    f32x4 gg[8];
    { const GAS f32x4* gr = (const GAS f32x4*)F.g_fin + 2 * lane;
#pragma unroll
      for (int j = 0; j < 8; ++j) gg[j] = gr[128 * (j >> 1) + (j & 1)]; }
    for (int m = gw; m < M; m += NGW) {
        const GAS v4u* xr = (const GAS v4u*)((const bf16*)F.X1 + (size_t)m * DM) + lane;
        const GAS v4u* y0 = (const GAS v4u*)(F.Y + (size_t)m * DM) + lane; const GAS v4u* y1 = (const GAS v4u*)(F.Y + (size_t)(M + m) * DM) + lane;
        f32x4 v[8]; float s = 0.f;
#pragma unroll
        for (int j = 0; j < 4; ++j) { const v4u x = xr[64 * j], a = y0[64 * j], c = y1[64 * j];
            v[2 * j] = (f32x4){bf_lo(x.x) + bf_lo(a.x) + bf_lo(c.x), bf_hi(x.x) + bf_hi(a.x) + bf_hi(c.x), bf_lo(x.y) + bf_lo(a.y) + bf_lo(c.y), bf_hi(x.y) + bf_hi(a.y) + bf_hi(c.y)};
            v[2 * j + 1] = (f32x4){bf_lo(x.z) + bf_lo(a.z) + bf_lo(c.z), bf_hi(x.z) + bf_hi(a.z) + bf_hi(c.z), bf_lo(x.w) + bf_lo(a.w) + bf_lo(c.w), bf_hi(x.w) + bf_hi(a.w) + bf_hi(c.w)}; }
#pragma unroll
        for (int j = 0; j < 8; ++j) s += (v[j].x * v[j].x + v[j].y * v[j].y) + (v[j].z * v[j].z + v[j].w * v[j].w);
        const float rstd = 1.0f / sqrtf(wave_sum(s) * (1.f / DM) + RMS_EPS);
        GAS f32x4* o = (GAS f32x4*)(F.out + (size_t)m * DM) + 2 * lane;
#pragma unroll
        for (int j = 0; j < 8; ++j) o[128 * (j >> 1) + (j & 1)] = (f32x4){v[j].x * rstd * gg[j].x, v[j].y * rstd * gg[j].y, v[j].z * rstd * gg[j].z, v[j].w * rstd * gg[j].w};
    }
}

__global__ void __launch_bounds__(NWAVES * 64, 2) skel_fwd(Args args) {
    extern __shared__ __attribute__((aligned(16))) unsigned char lds[];
    Frame F;
    F.lds = (LAS unsigned char*)lds;
    F.MISC = (volatile LAS unsigned*)(F.lds + MISC_OFF);
    F.tid = threadIdx.x; F.lane = F.tid & 63; F.wave = __builtin_amdgcn_readfirstlane(F.tid >> 6);
    F.G = gridDim.x; { const int bx = blockIdx.x; F.vcu = (F.G % 8 == 0) ? (bx % 8) * (F.G / 8) + bx / 8 : bx; }
    F.ctl = (gu32*)(args.ws + WS_CTL);
    for (int u = F.tid; u < (LDS_BYTES - LDSCTL_OFF) / 4; u += NWAVES * 64) ((LAS unsigned*)(F.lds + LDSCTL_OFF))[u] = 0u;
    __syncthreads();
    XcdBarrier bar; bar.bar = (unsigned*)(F.ctl + CW_BAR); bar.x = 0; bar.st = nullptr;
    if (N_LAUNCHES != PER_PHASE) bar = xcd_barrier_post((unsigned*)(F.ctl + CW_BAR), F.MISC + 8);
#define GRID_BAR(seam) do { if (N_LAUNCHES == PER_PHASE) { if (F.tid == 0) __hip_atomic_store(F.ctl + CW_TMO, 0xBADBA0u | (unsigned)(seam), RLX_AGENT); } else { xcd_barrier(bar); } } while (0)
    const int lo = args.ph_lo, hi = args.ph_hi;
#ifndef PH_MASK
#define PH_MASK 0x1ff
#endif
#define IN(k) (((PH_MASK >> (k)) & 1) && lo <= (k) && (k) < hi)
#define REP2(k, stmt) do { stmt; } while (0)
#define BOTH(k) (IN(k) && IN((k) + 1))

    if (IN(0)) { set_ptrs(F); REP2(0, p0_prologue(F)); if (BOTH(0)) GRID_BAR(0); }

    if (IN(1)) { set_ptrs(F);
        pg8::StaticOrder S; S.init(F.XN, F.WIN, M, INC, DM, F.G, (int)blockIdx.x);
        pg8::EpiBf16 E{F.PROJ, INC};
        REP2(1, (pg8::gemm_phase<pg8::EpiBf16, pg8::StaticOrder>(F.lds + RING_OFF, DM, S, E)));
        if (F.G == 256 && blockIdx.x >= 128) moe_items_wave(F, (((int)blockIdx.x - 128) * NWAVES + F.wave) * HID_P1, HID_P1);
        if (BOTH(1)) GRID_BAR(1);
    }

    if (IN(2)) { set_ptrs(F);
        unsigned char* ws_ = (unsigned char*)F.ctl;
        const bool xl2 = (N_LAUNCHES != PER_PHASE) && F.G == 256 && BOTH(2) && IN(0) && F.MISC[10] == 1u;
        { const int rk_ = (int)F.MISC[11]; const int u0 = xl2 ? ((rk_ >> 2) * 32 + (int)bar.x + 8 * (rk_ & 3)) : F.vcu, nu = (NB * NH * (SEQ / 64) - u0 + F.G - 1) / F.G;
          const int w = F.wave; int lane = F.lane; asm volatile("" : "+v"(lane));
          unsigned qw[8], fw[8], iw[8];
          if (nu > 0) { const int bh = u0 & 31, ch = u0 >> 5; const bf16* Pq = F.PROJ + (size_t)(bh >> 3) * SEQ * INC + 3 * AW + (bh & 7) * HD; HP_LOAD(ch); }
          for (int k = 0; k < nu; ++k) { const int u = u0 + k * F.G, bh = u & 31, ch = u >> 5, b = bh >> 3, h = bh & 7; const int un = u + F.G, chn = (k + 1 < nu && (un & 31) == bh) ? (un >> 5) : -1;
            const bf16* Pq = F.PROJ + (size_t)b * SEQ * INC + 3 * AW + h * HD;
            if (k > 0 && ((u - F.G) & 31) != bh) HP_LOAD(ch);
            hg::hgrn_produce(Pq, F.lb_logits + h * HD, ws_ + WS_HIMG + (size_t)(bh * 32 + ch) * hg::IMG_BYTES, ws_ + WS_HOI + (size_t)(bh * 32 + ch) * hg::OI_BYTES, F.lds + RING_OFF, ch, chn, qw, fw, iw); } }
        if (BOTH(2)) { if (xl2) xcd_local_barrier(bar, 1 + (int)(F.MISC[11] & 3u), F.MISC[11] < 4u, 8u); else GRID_BAR(2); }
    }

    if (IN(3)) { set_ptrs(F);
        const bool xl3 = (N_LAUNCHES != PER_PHASE) && F.G == 256 && IN(2) && IN(0) && F.MISC[10] == 1u;
        const int c = xl3 ? (int)(F.MISC[11] * 8u + bar.x) : (int)blockIdx.x;
#define ATTN_ITEM(it) attn_item_mfma(F, (char*)lds + RING_OFF, it)
#define P2_HG() do { if (F.G == 256) { if (c < 32) HGRN_SCAN(c); } else { for (int it = c; it < NB * NH; it += F.G) HGRN_SCAN(it); } } while (0)
#define P2_AT() do { const bool lpt_ = (F.G == 256); const int n_ = lpt_ ? (c < 32 ? 0 : (c >= 224 ? 2 : 1)) : (NB * NH * MOBA_NB - c + F.G - 1) / F.G; \
        for (int k_ = 0; k_ < n_; ++k_) { const int it = lpt_ ? (k_ == 0 ? c - 32 : 224 + (255 - c)) : c + k_ * F.G; ATTN_ITEM(it); } } while (0)
#define P2_FIN() do { const bool lpt_ = (F.G == 256); const int f_ = lpt_ ? (c < 32 ? c : (c >= 160 ? c - 128 : -1)) : c; const int nf_ = lpt_ ? 128 : F.G; \
        int last_bh_ = -1; \
        if (f_ >= 0) for (int u = f_; u < NB * NH * (SEQ / 64); u += nf_) { const int bh = u & 31, ch = u >> 5; \
            if (bh != last_bh_) { last_bh_ = bh; \
            if (F.tid == 0) { unsigned sp_ = 0; while (__hip_atomic_load(F.ctl + CW_HFLAG + 64 * bh, RLX_AGENT) == 0u && ++sp_ < (1u << 22)) __builtin_amdgcn_s_sleep(4); \
                __builtin_amdgcn_fence(__ATOMIC_ACQUIRE, "agent"); asm volatile("s_waitcnt vmcnt(0)" ::: "memory"); } \
            __syncthreads(); } \
            const unsigned char* ws_ = (const unsigned char*)F.ctl; \
            if (lpt_) { hg::hgrn_finish_run(ws_ + WS_HIMG + (size_t)(bh * 32) * hg::IMG_BYTES, ws_ + WS_HST + (size_t)(bh * 32) * hg::ST_BYTES, ws_ + WS_HOI + (size_t)(bh * 32) * hg::OI_BYTES, \
                F.PROJ + ((size_t)(bh >> 3) * SEQ) * INC + 3 * AW + (bh & 7) * HD + 3072, F.CAT + ((size_t)(bh >> 3) * SEQ) * DM + AW + (bh & 7) * HD, F.g_onorm, F.lds + RING_OFF, F.lds + FIN_SSQ_OFF, ch, 4, 8); break; } \
            hg::hgrn_finish(ws_ + WS_HIMG + (size_t)(bh * 32 + ch) * hg::IMG_BYTES, ws_ + WS_HST + (size_t)(bh * 32 + ch) * hg::ST_BYTES, ws_ + WS_HOI + (size_t)(bh * 32 + ch) * hg::OI_BYTES, \
                F.PROJ + ((size_t)(bh >> 3) * SEQ + ch * 64) * INC + 3 * AW + (bh & 7) * HD + 3072, F.CAT + ((size_t)(bh >> 3) * SEQ + ch * 64) * DM + AW + (bh & 7) * HD, F.g_onorm, F.lds + RING_OFF); } } while (0)
#define HGRN_SCAN(it) do { hg::hgrn_scan((const unsigned char*)F.ctl + WS_HIMG + (size_t)(it) * 32 * hg::IMG_BYTES, (unsigned char*)F.ctl + WS_HST + (size_t)(it) * 32 * hg::ST_BYTES, F.lds + RING_OFF, SEQ / 64); \
        asm volatile("s_waitcnt vmcnt(0)" ::: "memory"); __syncthreads(); \
        if (F.tid == 0) { if (!xl3) __builtin_amdgcn_fence(__ATOMIC_RELEASE, "agent");     \
            asm volatile("s_waitcnt vmcnt(0)" ::: "memory"); __hip_atomic_store(F.ctl + CW_HFLAG + 64 * (it), 1u, RLX_AGENT); } } while (0)
#define P2_CVT() do { if (F.G == 256) { const int cls_ = c < 32 ? 0 : 1 + ((c - 32) >> 5), wg_ = c < 32 ? c : (c - 32) & 31; \
        const int cnt_ = (int)((P3_CVT >> (8 * cls_)) & 255), base_ = N_HID_P1 + 256 * (int)((P3_CVT_PRE >> (8 * cls_)) & 255); \
        if (cnt_ > 0) { __syncthreads(); moe_items_wave(F, base_ + (wg_ * NWAVES + F.wave) * cnt_, cnt_); } } } while (0)
#define P2_BODY() do { P2_HG(); P2_AT(); P2_FIN(); P2_CVT(); } while (0)
        REP2(3, P2_BODY());
        if (BOTH(3)) GRID_BAR(3);
    }

    if (IN(4)) { set_ptrs(F);
        const bool xl = (N_LAUNCHES != PER_PHASE) && F.G == 256 && BOTH(4) && IN(0) && F.MISC[10] == 1u;
        pg8::StaticOrder S; S.init(F.CAT, F.WOUT, M, DM, DM, F.G, xl ? (int)(F.MISC[11] * 8u + bar.x) : (int)blockIdx.x, xl ? 4 : pg8::WGM);
        pg8::EpiResBf16 E{F.x, (pg8::bf16_t*)F.X1, DM};
        REP2(4, (pg8::gemm_phase<pg8::EpiResBf16, pg8::StaticOrder>(F.lds + RING_OFF, DM, S, E)));
        if (BOTH(4)) { if (xl) xcd_local_barrier(bar); else GRID_BAR(4); }
    }

    if (IN(5)) { set_ptrs(F);
        const bool xl = (N_LAUNCHES != PER_PHASE) && F.G == 256 && IN(4) && IN(0) && F.MISC[10] == 1u;
        const int vcu_ = F.vcu; if (xl) F.vcu = (int)(bar.x * 32u + F.MISC[11]);
        p4_router<false>(F); F.vcu = vcu_; if (BOTH(5)) GRID_BAR(5); }
    if (IN(6)) { set_ptrs(F);
        LAS int* pre = (LAS int*)(F.lds + MISC_OFF + 64);
        load_prefix(F, pre);
        pg8::GroupedOrder S{pre[NE], F.G, (int)blockIdx.x, (const char*)F.XN, (const char*)F.WGU, (size_t)0, (size_t)256 * DM, (size_t)2048 * DM, (const PG8_LAS int*)pre, (const PG8_LAS int*)(pre + 32), F.ROWL, F.WL};
        LAS int* rowsL = (LAS int*)(F.lds + 131072);
        LAS float* wlL = (LAS float*)(F.lds + WLL_OFF);
        for (int i = 0; i < 16; ++i) { pg8::Unit u; if (!S.next(i, u)) break; if (F.tid < 256) rowsL[i * 256 + F.tid] = (F.tid < u.nvalid) ? (u.rows[F.tid] & 0xffff) : 0;
            else if (i < 8) wlL[i * 256 + F.tid - 256] = (F.tid - 256 < u.nvalid) ? 4.f * u.wl[F.tid - 256] : 0.f; }
        __syncthreads();
        pg8::EpiSwiGlu8 E{(unsigned char*)F.HID, (const PG8_LAS float*)wlL};
        REP2(6, (pg8::gemm_phase<pg8::EpiSwiGlu8, pg8::GroupedOrder, true, 0x7f7f7f7f, 0x79797979, true>(F.lds + RING_OFF, DM, S, E, (const PG8_LAS int*)rowsL)));
        if (F.G == 256) {
            const int U = pre[NE] * 8, nb = U - ((U - 1) / 256) * 256, nidle = 256 - nb, c = (int)blockIdx.x;
            __syncthreads();
            LAS float* scr = (LAS float*)(F.lds + RING_OFF + F.wave * 16384);
            if (nidle >= 32) { if (c >= nb) for (int i = (c - nb) * NWAVES + F.wave; i < N_HID_P7; i += nidle * NWAVES) moe_item(F, I_MOE - N_HID_P7 + i, scr, F.lane); }
            else for (int i = c * NWAVES + F.wave; i < N_HID_P7; i += 256 * NWAVES) moe_item(F, I_MOE - N_HID_P7 + i, scr, F.lane);
        }
        if (BOTH(6)) GRID_BAR(6);
    }

    if (IN(7)) { set_ptrs(F);
        LAS int* pre = (LAS int*)(F.lds + MISC_OFF + 64);
        load_prefix(F, pre);
        pg8::GroupedOrder S{pre[NE], F.G, (int)blockIdx.x, (const char*)F.HID, (const char*)F.WD, (size_t)256 * DE, (size_t)256 * DE, (size_t)DM * DE, (const PG8_LAS int*)pre, (const PG8_LAS int*)(pre + 32), F.ROWL, F.WL};
        pg8::EpiScatter E{F.Y};
        REP2(7, (pg8::gemm_phase<pg8::EpiScatter, pg8::GroupedOrder, true, 0x7d7d7d7d, 0x7a7a7a7a>(F.lds + RING_OFF, DE, S, E)));
        if (BOTH(7)) GRID_BAR(7);
    }

    if (IN(8)) { set_ptrs(F); REP2(8, p7_final(F)); }
#undef IN
#undef BOTH
}

extern "C" void kernel_launch(void* const* d_in, const int* in_sizes, int n_in, void* d_out, int out_size, void* d_ws, size_t ws_size, hipStream_t stream) {
    static int grid = 0;
    if (grid == 0) {
        if (n_in != 15 || in_sizes[0] != M * DM || out_size != M * DM || ws_size < 504 * MiB) { fprintf(stderr, "kernel_launch: unexpected shapes (n_in %d, in0 %d, out %d, ws %zu < %zu)\n", n_in, n_in > 0 ? in_sizes[0] : -1, out_size, ws_size, (size_t)WS_END); grid = -1; return; }
        int dev = 0, cus = 0, per_cu = 0;
        if (hipGetDevice(&dev) != hipSuccess || hipDeviceGetAttribute(&cus, hipDeviceAttributeMultiprocessorCount, dev) != hipSuccess) { grid = -1; return; }
        if (hipFuncSetAttribute((const void*)skel_fwd, hipFuncAttributeMaxDynamicSharedMemorySize, LDS_BYTES) != hipSuccess) { fprintf(stderr, "kernel_launch: hipFuncSetAttribute failed\n"); grid = -1; return; }
        if (hipOccupancyMaxActiveBlocksPerMultiprocessor(&per_cu, (const void*)skel_fwd, NWAVES * 64, LDS_BYTES) != hipSuccess || per_cu < 1) { fprintf(stderr, "kernel_launch: occupancy query says %d blocks per CU\n", per_cu); grid = -1; (void)hipGetLastError(); return; }
        grid = cus;
    }
    if (grid < 0) return;
    if (hipMemsetAsync((char*)d_ws + WS_CTL, 0, CTL_ZERO_BYTES, stream) != hipSuccess) return;
    Args a{};
    for (int i = 0; i < 15; ++i) a.in[i] = (const float*)d_in[i];
    a.out = (float*)d_out; a.ws = (unsigned char*)d_ws;
    for (int li = 0; li < N_LAUNCHES; ++li) {
        a.ph_lo = (N_LAUNCHES == PER_PHASE) ? li : 0; a.ph_hi = (N_LAUNCHES == PER_PHASE) ? li + 1 : PER_PHASE; a.li = li;
        hipLaunchKernelGGL(skel_fwd, dim3(grid), dim3(NWAVES * 64), LDS_BYTES, stream, a);
        if (N_LAUNCHES != PER_PHASE) break;
    }
}
```
